# Optimizing an MI355X kernel written in HIP

```python
import math
import jax, jax.numpy as jnp
from jax import lax
import numpy as np

D_MODEL = 1024
BATCH = 2
SEQ = 8192
DEPTH = 4
DEC_BATCH = 128
DEC_SEQ = 4
PAST_LEN = 8192
PAGE_SIZE = 128

D_MIX = D_MODEL
HEAD_DIM = 64
ATT_WIDTH = D_MIX // 2
ATT_HEADS = ATT_WIDTH // HEAD_DIM
ATT_KV_HEADS = ATT_HEADS // 4
GROUP = ATT_HEADS // ATT_KV_HEADS
KV_WIDTH = ATT_KV_HEADS * HEAD_DIM
WINDOW = 128
ROPE_DIM = HEAD_DIM // 4
ROPE_THETA = 500000.0
DN_DK = 128
DN_DV = 128
DN_WIDTH = D_MIX - ATT_WIDTH
DN_HEADS = DN_WIDTH // DN_DV
DN_CONV_CH = DN_HEADS * (2 * DN_DK + DN_DV)
CONV_W = 4
CHUNK = 64
N_IN = 2 * ATT_WIDTH + 2 * KV_WIDTH + DN_CONV_CH + DN_WIDTH + 2 * DN_HEADS
EPS = 1e-6

kernel_name = 'hybrid_swa_sink_gated_delta_step'

F32 = jnp.float32


def _rms(x, g):
    xf = x.astype(F32)
    y = xf * lax.rsqrt(jnp.mean(xf * xf, -1, keepdims=True) + EPS)
    return (y * g.astype(F32)).astype(x.dtype)


def _l2n(x):
    xf = x.astype(F32)
    return xf * lax.rsqrt(jnp.sum(xf * xf, -1, keepdims=True) + EPS)


def _rope(x, pos):
    half = ROPE_DIM // 2
    inv = jnp.power(jnp.float32(ROPE_THETA), -jnp.arange(half, dtype=F32) / half)
    ang = pos.astype(F32)[:, None] * inv[None, :]
    cos = jnp.cos(ang)[:, None, :]
    sin = jnp.sin(ang)[:, None, :]
    xf = x.astype(F32)
    x1, x2, rest = xf[..., :half], xf[..., half:ROPE_DIM], xf[..., ROPE_DIM:]
    out = jnp.concatenate([x1 * cos - x2 * sin, x2 * cos + x1 * sin, rest], -1)
    return out.astype(x.dtype)


def _split_cols(z):
    sizes = (ATT_WIDTH, KV_WIDTH, KV_WIDTH, ATT_WIDTH, DN_CONV_CH, DN_WIDTH, DN_HEADS, DN_HEADS)
    idx = [int(i) for i in np.cumsum(sizes)[:-1]]
    return jnp.split(z, idx, axis=-1)


def _sink_attend(q, k, v, mask, sinks):
    s = jnp.einsum('...qkgd,...skd->...kgqs', q.astype(F32), k.astype(F32)) * (HEAD_DIM ** -0.5)
    s = jnp.where(mask, s, -jnp.inf)
    sink = sinks.astype(F32).reshape(ATT_KV_HEADS, GROUP, 1, 1)
    m = jnp.maximum(jnp.max(s, -1, keepdims=True), sink)
    p = jnp.exp(s - m)
    denom = jnp.sum(p, -1, keepdims=True) + jnp.exp(sink - m)
    o = jnp.einsum('...kgqs,...skd->...qkgd', p / denom, v.astype(F32))
    return o.astype(q.dtype)


def _swa_banded(q, k, v, sinks):
    B, S = q.shape[:2]
    nb = S // WINDOW
    qb = q.reshape(B, nb, WINDOW, ATT_KV_HEADS, GROUP, HEAD_DIM)

    def with_prev(t):
        t = t.reshape(B, nb, WINDOW, ATT_KV_HEADS, HEAD_DIM)
        prev = jnp.concatenate([jnp.zeros_like(t[:, :1]), t[:, :-1]], axis=1)
        return jnp.concatenate([prev, t], axis=2)

    i = jnp.arange(WINDOW)[:, None] + WINDOW
    j = jnp.arange(2 * WINDOW)[None, :]
    band = (j <= i) & (j > i - WINDOW)
    first = (jnp.arange(nb)[:, None, None] > 0) | (j >= WINDOW)[None]
    mask = (band[None] & first)[:, None, None]
    o = _sink_attend(qb, with_prev(k), with_prev(v), mask, sinks)
    return o.reshape(B, S, ATT_WIDTH)


def _swa_cached(q, k, v, win_k, win_v, sinks):
    B, L = q.shape[:2]
    wb = win_k.shape[1]
    kk = jnp.concatenate([win_k.astype(k.dtype), k], 1)
    vv = jnp.concatenate([win_v.astype(v.dtype), v], 1)
    kpos = PAST_LEN - wb + jnp.arange(wb + L)
    qpos = PAST_LEN + jnp.arange(L)
    mask = (kpos[None, :] <= qpos[:, None]) & (kpos[None, :] > qpos[:, None] - WINDOW)
    o = _sink_attend(q.reshape(B, L, ATT_KV_HEADS, GROUP, HEAD_DIM), kk, vv, mask, sinks)
    return o.reshape(B, L, ATT_WIDTH), kk[:, -wb:], vv[:, -wb:]


def _gated_delta(q, k, v, beta, g, s0):
    B, L, H, DK = q.shape
    DV = v.shape[-1]
    c = min(CHUNK, L)
    pad = (-L) % c
    n = (L + pad) // c

    def prep(t):
        t = jnp.pad(t.astype(F32), [(0, 0), (0, pad)] + [(0, 0)] * (t.ndim - 2))
        t = t.reshape((B, n, c) + t.shape[2:])
        return jnp.moveaxis(t, 3, 2)

    q, k, v, beta, g = prep(q), prep(k), prep(v), prep(beta), prep(g)
    G = jnp.cumsum(g, axis=-1)
    ci = jnp.arange(c)
    causal = ci[:, None] >= ci[None, :]
    strict = ci[:, None] > ci[None, :]
    decay = jnp.exp(jnp.where(causal, G[..., :, None] - G[..., None, :], -jnp.inf))
    kb = k * beta[..., None]
    a_kk = jnp.where(strict, jnp.einsum('bnhid,bnhjd->bnhij', kb, k) * decay, 0.0)
    rhs = jnp.concatenate([v * beta[..., None], kb * jnp.exp(G)[..., None]], -1)
    sol = lax.linalg.triangular_solve(a_kk, rhs, left_side=True, lower=True, unit_diagonal=True)
    u, w = sol[..., :DV], sol[..., DV:]
    a_qk = jnp.einsum('bnhid,bnhjd->bnhij', q, k) * decay
    qg = q * jnp.exp(G)[..., None]
    kd = k * jnp.exp(G[..., -1:] - G)[..., None]
    gl = jnp.exp(G[..., -1])
    xs = tuple(jnp.moveaxis(t, 1, 0) for t in (u, w, a_qk, qg, kd, gl))

    def step(S, inp):
        u_c, w_c, aqk_c, qg_c, kd_c, gl_c = inp
        vnew = u_c - jnp.einsum('bhck,bhkv->bhcv', w_c, S)
        o = jnp.einsum('bhck,bhkv->bhcv', qg_c, S) + jnp.einsum('bhij,bhjv->bhiv', aqk_c, vnew)
        S = S * gl_c[..., None, None] + jnp.einsum('bhck,bhcv->bhkv', kd_c, vnew)
        return S, o

    S, o = lax.scan(step, s0.astype(F32), xs)
    o = jnp.moveaxis(o, 0, 1)
    o = jnp.moveaxis(o, 2, 3).reshape(B, n * c, H, DV)[:, :L]
    return o, S


def _delta_branch(dqkv, dg, db, da, conv_buf, s0, conv_w, a_log, dt_bias, dn_norm_g):
    B, L = dqkv.shape[:2]
    xx = jnp.concatenate([conv_buf.astype(dqkv.dtype), dqkv], 1)
    y = xx[:, 0:L] * conv_w[0]
    for j in range(1, CONV_W):
        y = y + xx[:, j:j + L] * conv_w[j]
    y = jax.nn.silu(y)
    new_buf = xx[:, xx.shape[1] - (CONV_W - 1):]
    q, k, v = jnp.split(y, [DN_HEADS * DN_DK, 2 * DN_HEADS * DN_DK], -1)
    q = _l2n(q.reshape(B, L, DN_HEADS, DN_DK)) * (DN_DK ** -0.5)
    k = _l2n(k.reshape(B, L, DN_HEADS, DN_DK))
    v = v.reshape(B, L, DN_HEADS, DN_DV)
    beta = jax.nn.sigmoid(db.astype(F32))
    g = -jnp.exp(a_log.astype(F32)) * jax.nn.softplus(da.astype(F32) + dt_bias.astype(F32))
    o, s_new = _gated_delta(q, k, v, beta, g, s0)
    o = _rms(o, dn_norm_g) * jax.nn.silu(dg.astype(F32).reshape(B, L, DN_HEADS, DN_DV))
    return o.reshape(B, L, DN_WIDTH).astype(dqkv.dtype), new_buf, s_new


def _layer(x, pos, win_k, win_v, conv_buf, s0, norm_g, w_in, q_norm_g, k_norm_g, sinks,
           conv_w, a_log, dt_bias, dn_norm_g, w_out):
    B, L, _ = x.shape
    z = jnp.einsum('bld,de->ble', _rms(x, norm_g), w_in)
    aq, ak, av, ag, dqkv, dg, db, da = _split_cols(z)
    q = _rope(_rms(aq.reshape(B, L, ATT_HEADS, HEAD_DIM), q_norm_g), pos)
    k = _rope(_rms(ak.reshape(B, L, ATT_KV_HEADS, HEAD_DIM), k_norm_g), pos)
    v = av.reshape(B, L, ATT_KV_HEADS, HEAD_DIM)
    if win_k is None:
        att = _swa_banded(q, k, v, sinks)
        wb = min(WINDOW, L)
        nk, nv = k[:, L - wb:], v[:, L - wb:]
    else:
        att, nk, nv = _swa_cached(q, k, v, win_k, win_v, sinks)
    att = att * jax.nn.silu(ag)
    dn, nbuf, ns = _delta_branch(dqkv, dg, db, da, conv_buf, s0, conv_w, a_log, dt_bias, dn_norm_g)
    y = jnp.einsum('ble,ed->bld', jnp.concatenate([att, dn], -1), w_out)
    return x + y, nk, nv, nbuf, ns


def setup_inputs(seed: int = 0) -> dict:
    key = jax.random.key(seed)
    ks = jax.random.split(key, 20)
    wb = min(WINDOW, PAST_LEN)
    nrm = jax.random.normal
    x_prompt = nrm(ks[0], (BATCH, SEQ, D_MODEL), F32)
    x_sample = nrm(ks[1], (DEC_BATCH, DEC_SEQ, D_MODEL), F32)
    cache_win_k = nrm(ks[2], (DEPTH, DEC_BATCH, wb, ATT_KV_HEADS, HEAD_DIM), F32)
    cache_win_v = nrm(ks[3], (DEPTH, DEC_BATCH, wb, ATT_KV_HEADS, HEAD_DIM), F32)
    state_conv = nrm(ks[4], (DEPTH, DEC_BATCH, CONV_W - 1, DN_CONV_CH), F32)
    state_delta = 0.1 * nrm(ks[5], (DEPTH, DEC_BATCH, DN_HEADS, DN_DK, DN_DV), F32)
    norm_g = 1.0 + 0.02 * nrm(ks[6], (DEPTH, D_MODEL), F32)
    w_in = nrm(ks[7], (DEPTH, D_MODEL, N_IN), F32) * (D_MODEL ** -0.5)
    q_norm_g = 1.0 + 0.02 * nrm(ks[8], (DEPTH, HEAD_DIM), F32)
    k_norm_g = 1.0 + 0.02 * nrm(ks[9], (DEPTH, HEAD_DIM), F32)
    sinks = 0.5 * nrm(ks[10], (DEPTH, ATT_HEADS), F32)
    conv_w = nrm(ks[11], (DEPTH, CONV_W, DN_CONV_CH), F32) * (CONV_W ** -0.5)
    a_log = jnp.log(jax.random.uniform(ks[12], (DEPTH, DN_HEADS), F32, 1.0, 16.0))
    dt = jnp.exp(jax.random.uniform(ks[13], (DEPTH, DN_HEADS), F32, math.log(1e-3), math.log(1e-1)))
    dt_bias = dt + jnp.log(-jnp.expm1(-dt))
    dn_norm_g = 1.0 + 0.02 * nrm(ks[14], (DEPTH, DN_DV), F32)
    w_out = nrm(ks[15], (DEPTH, D_MIX, D_MODEL), F32) * (D_MIX ** -0.5)
    return {'x_prompt': x_prompt, 'x_sample': x_sample, 'cache_win_k': cache_win_k,
            'cache_win_v': cache_win_v, 'state_conv': state_conv, 'state_delta': state_delta,
            'norm_g': norm_g, 'w_in': w_in, 'q_norm_g': q_norm_g, 'k_norm_g': k_norm_g,
            'sinks': sinks, 'conv_w': conv_w, 'a_log': a_log, 'dt_bias': dt_bias,
            'dn_norm_g': dn_norm_g, 'w_out': w_out}


def reference(x_prompt, x_sample, cache_win_k, cache_win_v, state_conv, state_delta,
              norm_g, w_in, q_norm_g, k_norm_g, sinks, conv_w, a_log, dt_bias, dn_norm_g, w_out):
    bp, lp = x_prompt.shape[:2]
    ls = x_sample.shape[1]
    pos_p = jnp.arange(lp)
    pos_s = PAST_LEN + jnp.arange(ls)
    xp, xs = x_prompt, x_sample
    pk, pv, pc, pd, sk, sv, sc, sd = [], [], [], [], [], [], [], []
    for l in range(DEPTH):
        w = (norm_g[l], w_in[l], q_norm_g[l], k_norm_g[l], sinks[l], conv_w[l], a_log[l],
             dt_bias[l], dn_norm_g[l], w_out[l])
        buf0 = jnp.zeros((bp, CONV_W - 1, DN_CONV_CH), xp.dtype)
        s0 = jnp.zeros((bp, DN_HEADS, DN_DK, DN_DV), F32)
        xp, k1, v1, c1, d1 = _layer(xp, pos_p, None, None, buf0, s0, *w)
        xs, k2, v2, c2, d2 = _layer(xs, pos_s, cache_win_k[l], cache_win_v[l], state_conv[l],
                                    state_delta[l], *w)
        pk.append(k1); pv.append(v1); pc.append(c1); pd.append(d1.astype(x_prompt.dtype))
        sk.append(k2); sv.append(v2); sc.append(c2); sd.append(d2.astype(state_delta.dtype))
    return (xp, xs, jnp.stack(pk), jnp.stack(pv), jnp.stack(pc), jnp.stack(pd),
            jnp.stack(sk), jnp.stack(sv), jnp.stack(sc), jnp.stack(sd))
```

```cpp
#include <hip/hip_runtime.h>
#include <hip/hip_cooperative_groups.h>
#include <cstdio>
#include <cstdint>
namespace cg = cooperative_groups;
#define DI __device__ __forceinline__
namespace pg8 {
#define PG8_LAS __attribute__((address_space(3)))
typedef unsigned short bf16_t;
typedef short bf16x8 __attribute__((ext_vector_type(8)));
typedef float f32x4 __attribute__((ext_vector_type(4)));
typedef unsigned u32x4 __attribute__((ext_vector_type(4)));
constexpr int BM = 256, BK = 64, HALF = 128, HTB = HALF * BK * 2  , STAGE_BYTES = 8 * HTB, NXCD = 8, WGM = 8;

__host__ __device__ __forceinline__ int lds_byte(int r, int c) { const int st = (r >> 4) * 2 + (c >> 5), rr = r & 15, cc = c & 31, ob = rr * 64 + cc * 2; return st * 1024 + (ob ^ (((ob >> 9) & 1) << 5)); }
__host__ __device__ __forceinline__ void stage_rc(int b, int& R, int& C) { const int st = b / 1024, sb = b % 1024, swz = sb ^ (((sb >> 9) & 1) << 5); R = (st >> 1) * 16 + swz / 64; C = (st & 1) * 32 + (swz % 64) / 2; }
__host__ __device__ __forceinline__ int perm32(int rho) { const int n = rho >> 4, i = rho & 15; return 8 * (i >> 2) + 4 * n + (i & 3); }

struct Unit { int pm, pn; };
struct Gemm { const bf16_t* A; const bf16_t* Bt; int M, N, K; };

struct StaticOrder {
    int nM, nN, nwg, G, c;
    __host__ __device__ void init(int M, int N, int G_, int c_) { nM = M / BM; nN = N / BM; nwg = nM * nN; G = G_; c = c_; }
    __host__ __device__ bool next(int i, Unit& u) const {
        const long L = (long)i * G + c; if (L >= nwg) return false;
        int wgid = (int)L; { const int q = nwg / NXCD, r = nwg % NXCD, xcd = wgid % NXCD, off = wgid / NXCD; wgid = (xcd < r ? xcd * (q + 1) : r * (q + 1) + (xcd - r) * q) + off; }
        const int nig = WGM * nN, gid = wgid / nig, fm = gid * WGM, gsz = (nM - fm) < WGM ? (nM - fm) : WGM;
        u.pm = fm + ((wgid % nig) % gsz); u.pn = (wgid % nig) / gsz; return true;
    }
    __device__ __forceinline__ void a_ready(const Unit&) const {}
    __device__ __forceinline__ void done(const Unit&) const {}
};
__device__ __forceinline__ unsigned cvt_pk_bf16(float lo, float hi) { unsigned r; asm volatile("v_cvt_pk_bf16_f32 %0, %1, %2" : "=v"(r) : "v"(lo), "v"(hi)); return r; }
template <class Epi, class Sched, bool STAMP = false>
__device__ __forceinline__ void gemm_phase(PG8_LAS unsigned char* lds, const Gemm g, const Sched& S, const Epi& E, unsigned long long* stamps, const int tid_in) {
    const int tid = tid_in, wid = __builtin_amdgcn_readfirstlane(tid >> 6), lane = tid & 63, wr = wid >> 2, wc = wid & 3, fr = lane & 15, fq = lane >> 4;
    const int K = g.K, nt = K / BK;
    int ts_lo = 0, ts_hi = 0, nts = 0; const unsigned long long rt_entry = STAMP ? (unsigned long long)wall_clock64() : 0ull;
#define PG8_STAMP() do { if (STAMP && wid == 0 && nts < 64) { const unsigned long long _c = (unsigned long long)clock64(); \
        ts_lo = (lane == nts) ? (int)(unsigned)_c : ts_lo; ts_hi = (lane == nts) ? (int)(unsigned)(_c >> 32) : ts_hi; ++nts; } } while (0)
    PG8_STAMP();
    unsigned voffA[2], voffB[2];
#pragma unroll
    for (int i = 0; i < 2; ++i) { int R, C; stage_rc(tid * 16 + i * 8192, R, C); const int Rb = Epi::PERM ? ((R & ~31) + perm32(R & 31)) : R;
        voffA[i] = (unsigned)(R * K + C) * 2u; voffB[i] = (unsigned)(Rb * K + C) * 2u; }
    const size_t kstep = (size_t)(BK * 2);
    const size_t hstep = (size_t)HALF * K * 2;
    const size_t tstep = 2 * hstep;
    const unsigned ldsw = (unsigned)wid * 1024u;
    const int aoff = lds_byte(wr * 64 + fr, fq * 8), boff = lds_byte(wc * 32 + fr, fq * 8);
#define PG8_SA(b, h) (((b) * 2 + (h)) * HTB)
#define PG8_SB(b, h) ((4 + (b) * 2 + (h)) * HTB)
#define PG8_STAGE(bufoff, gbase, voff) do { _Pragma("unroll") for (int _i = 0; _i < 2; ++_i) \
        __builtin_amdgcn_global_load_lds((const unsigned*)((const char*)(gbase) + (voff)[_i]), (PG8_LAS unsigned*)(lds + (bufoff) + ldsw + _i * 8192), 16, 0, 0); } while (0)
#define PG8_LDA(dst, b, h) do { _Pragma("unroll") for (int m = 0; m < 4; ++m) _Pragma("unroll") for (int k = 0; k < 2; ++k) dst[m][k] = *(const PG8_LAS bf16x8*)(lds + PG8_SA(b, h) + aoff + m * 2048 + k * 1024); } while (0)
#define PG8_LDB(dst, b, h) do { _Pragma("unroll") for (int n = 0; n < 2; ++n) _Pragma("unroll") for (int k = 0; k < 2; ++k) dst[n][k] = *(const PG8_LAS bf16x8*)(lds + PG8_SB(b, h) + boff + n * 2048 + k * 1024); } while (0)
#define PG8_MMA(ai, bj, At, Bt) do { __builtin_amdgcn_s_setprio(1); _Pragma("unroll") for (int m = 0; m < 4; ++m) _Pragma("unroll") for (int n = 0; n < 2; ++n) _Pragma("unroll") for (int k = 0; k < 2; ++k) \
        acc[ai][bj][m][n] = __builtin_amdgcn_mfma_f32_16x16x32_bf16(Bt[n][k], At[m][k], acc[ai][bj][m][n], 0, 0, 0); __builtin_amdgcn_s_setprio(0); } while (0)
#define PG8_WAIT_V(n) asm volatile("s_waitcnt vmcnt(" #n ")" ::: "memory")
#define PG8_WAIT_L(n) asm volatile("s_waitcnt lgkmcnt(" #n ")" ::: "memory")
#define PG8_BAR __builtin_amdgcn_s_barrier()
#define PG8_SCHED __builtin_amdgcn_sched_barrier(0)
    Unit cur, nxt; int ui = 0;
    if (!S.next(0, cur)) return;
    f32x4 acc[2][2][4][2];
#pragma unroll
    for (int a = 0; a < 2; ++a)
#pragma unroll
        for (int b = 0; b < 2; ++b)
#pragma unroll
            for (int m = 0; m < 4; ++m)
#pragma unroll
                for (int n = 0; n < 2; ++n) acc[a][b][m][n] = (f32x4){0.f, 0.f, 0.f, 0.f};
    bf16x8 At[4][2], B0[2][2], B1[2][2];
    const char* cA = (const char*)g.A + (size_t)cur.pm * tstep; const char* cB = (const char*)g.Bt + (size_t)cur.pn * tstep;
    S.a_ready(cur);
    PG8_STAGE(PG8_SB(0, 0), cB, voffB); PG8_STAGE(PG8_SA(0, 0), cA, voffA); PG8_STAGE(PG8_SB(0, 1), cB + hstep, voffB); PG8_STAGE(PG8_SA(0, 1), cA + hstep, voffA);
    if (wr == 1) PG8_BAR;
    PG8_WAIT_V(4); PG8_BAR;
    PG8_STAGE(PG8_SB(1, 0), cB + kstep, voffB); PG8_STAGE(PG8_SA(1, 0), cA + kstep, voffA); PG8_STAGE(PG8_SB(1, 1), cB + hstep + kstep, voffB);
    PG8_WAIT_V(6); PG8_BAR;
    PG8_STAMP();
    for (;;) {
        const bool has_next = S.next(ui + 1, nxt);
        const char* nA = has_next ? (const char*)g.A + (size_t)nxt.pm * tstep : cA; const char* nB = has_next ? (const char*)g.Bt + (size_t)nxt.pn * tstep : cB;
        for (int t = 0; t < nt; t += 2) {
            const bool last = (t == nt - 2);
            const char* a1 = cA + (size_t)(t + 1) * kstep;
            const char* a2 = last ? nA : cA + (size_t)(t + 2) * kstep; const char* b2 = last ? nB : cB + (size_t)(t + 2) * kstep;
            const char* a3 = a2 + kstep; const char* b3 = b2 + kstep;
            if (last && has_next) S.a_ready(nxt);
            PG8_LDB(B0, 0, 0); PG8_SCHED; PG8_LDA(At, 0, 0); PG8_STAGE(PG8_SA(1, 1), a1 + hstep, voffA);
            PG8_WAIT_L(8); PG8_BAR; PG8_WAIT_L(0); PG8_MMA(0, 0, At, B0); PG8_BAR; PG8_SCHED;
            PG8_LDB(B1, 0, 1); PG8_STAGE(PG8_SB(0, 0), b2, voffB);
            PG8_BAR; PG8_WAIT_L(0); PG8_MMA(0, 1, At, B1); PG8_BAR;
            PG8_LDA(At, 0, 1); PG8_STAGE(PG8_SA(0, 0), a2, voffA);
            PG8_BAR; PG8_WAIT_L(0); PG8_MMA(1, 0, At, B0); PG8_BAR; PG8_SCHED;
            PG8_STAGE(PG8_SB(0, 1), b2 + hstep, voffB);
            PG8_WAIT_V(6); PG8_BAR; PG8_MMA(1, 1, At, B1); PG8_BAR;
            PG8_LDB(B0, 1, 0); PG8_SCHED; PG8_LDA(At, 1, 0); PG8_STAGE(PG8_SA(0, 1), a2 + hstep, voffA);
            PG8_WAIT_L(8); PG8_BAR; PG8_WAIT_L(0); PG8_MMA(0, 0, At, B0); PG8_BAR; PG8_SCHED;
            PG8_LDB(B1, 1, 1); PG8_STAGE(PG8_SB(1, 0), b3, voffB);
            PG8_BAR; PG8_WAIT_L(0); PG8_MMA(0, 1, At, B1); PG8_BAR;
            PG8_LDA(At, 1, 1); PG8_STAGE(PG8_SA(1, 0), a3, voffA);
            PG8_BAR; PG8_WAIT_L(0); PG8_MMA(1, 0, At, B0); PG8_BAR; PG8_SCHED;
            PG8_STAGE(PG8_SB(1, 1), b3 + hstep, voffB);
            PG8_WAIT_V(6); PG8_BAR; PG8_MMA(1, 1, At, B1); PG8_BAR;
        }
        PG8_STAMP();
        if constexpr (!Epi::AFTER_DRAIN) { E(acc, cur, wr, wc, fr, fq); S.done(cur); }
        PG8_STAMP();
        if (!has_next) break;
#pragma unroll
        for (int a = 0; a < 2; ++a)
#pragma unroll
            for (int b = 0; b < 2; ++b)
#pragma unroll
                for (int m = 0; m < 4; ++m)
#pragma unroll
                    for (int n = 0; n < 2; ++n) acc[a][b][m][n] = (f32x4){0.f, 0.f, 0.f, 0.f};
        cur = nxt; cA = nA; cB = nB; ++ui;
    }
    PG8_WAIT_V(0);
    if (wr == 0) PG8_BAR;
    PG8_BAR;
    if constexpr (Epi::AFTER_DRAIN) { E.fused(acc, cur, wr, wc, fr, fq, lds, wid, lane); S.done(cur); }
    PG8_STAMP();
    if (STAMP && wid == 0) { stamps[lane] = lane < nts ? (((unsigned long long)(unsigned)ts_hi << 32) | (unsigned)ts_lo) : 0ull;
        if (lane == 62) stamps[62] = rt_entry; if (lane == 63) stamps[63] = (unsigned long long)wall_clock64(); }
#undef PG8_STAMP
#undef PG8_SA
#undef PG8_SB
#undef PG8_STAGE
#undef PG8_LDA
#undef PG8_LDB
#undef PG8_MMA
#undef PG8_WAIT_V
#undef PG8_WAIT_L
#undef PG8_BAR
#undef PG8_SCHED
}
}

using pg8::bf16_t; using pg8::bf16x8; using pg8::f32x4; using pg8::u32x4; using pg8::cvt_pk_bf16;
typedef unsigned u32x2 __attribute__((ext_vector_type(2)));

constexpr int MP = 16384, MS = 512, MT = MP + MS, DM = 1024, ZS = 3328, NPAD = 3584, NIN = 3336;
constexpr float EPSF = 1e-6f;
constexpr int C_AQ = 0, C_AK = 512, C_AV = 640, C_AG = 768, C_DQKV = 1280, C_DG = 2816;
constexpr size_t O_YP = 0, O_YS = 16777216, O_PWK = 17301504, O_PWV = 17432576, O_PCONV = 17563648, O_PDELTA = 17600512,
                 O_SWK = 18124800, O_SWV = 26513408, O_SCONV = 34902016, O_SDELTA = 37261312;
constexpr size_t W_WINT = 0, W_WOUTT = W_WINT + (size_t)4 * NPAD * DM * 2, W_XB = W_WOUTT + (size_t)4 * DM * DM * 2,
                 W_Z = W_XB + (size_t)MT * DM * 2, W_Z8 = W_Z + (size_t)MT * ZS * 2, W_SS = W_Z8 + (size_t)MT * 8 * 4,
                 W_MIX = W_SS + (size_t)4 * MT * 4, W_PU = W_MIX + (size_t)MT * DM * 2, W_PW = W_PU + (size_t)1024 * 32768,
                 W_PQG = W_PW + (size_t)1024 * 16384, W_PKD = W_PQG + (size_t)1024 * 16384, W_PAQK = W_PKD + (size_t)1024 * 16384,
                 W_PGL = W_PAQK + (size_t)1024 * 8192, W_PG = W_PGL + 4096, W_END = W_PG + (size_t)1024 * 16384;
constexpr int LDS_BYTES = 147456;

struct Params {
    const float *x_prompt, *x_sample, *cache_k, *cache_v, *state_conv, *state_delta, *norm_g, *w_in, *q_norm_g, *k_norm_g, *sinks, *conv_w, *a_log,
        *dt_bias, *dn_norm_g, *w_out;
    float* out; unsigned char* ws;
    int phase_lo, phase_hi, coop, pad;
};

DI float bf2f(bf16_t b) { return __uint_as_float(((unsigned)b) << 16); }
DI bf16_t f2bf(float f) { unsigned u = __float_as_uint(f); u += 0x7fffu + ((u >> 16) & 1u); return (bf16_t)(u >> 16); }
DI unsigned pk2(float lo, float hi) { return (unsigned)f2bf(lo) | ((unsigned)f2bf(hi) << 16); }
DI float lo16(unsigned w) { return __uint_as_float(w << 16); }
DI float hi16(unsigned w) { return __uint_as_float(w & 0xffff0000u); }
DI float wave_sum(float v) {
#pragma unroll
    for (int o = 1; o < 64; o <<= 1) v += __shfl_xor(v, o);
    return v;
}
DI float wave_max(float v) {
#pragma unroll
    for (int o = 1; o < 64; o <<= 1) v = fmaxf(v, __shfl_xor(v, o));
    return v;
}
DI float siluf(float x) { return x / (1.0f + __expf(-x)); }
DI float sigmoidf_(float x) { return 1.0f / (1.0f + __expf(-x)); }
DI float softplusf_(float x) { return x > 20.f ? x : log1pf(expf(x)); }
DI float rope_inv(int i) { return exp2f(-(float)i * (18.931568569324174f / 8.0f)); }
DI void sincos_rev(float ang, float& sn, float& cs) {
    double a = (double)ang * 0.15915494309189535; a -= rint(a);
    const float r = (float)a; sn = __builtin_amdgcn_sinf(r); cs = __builtin_amdgcn_cosf(r);
}
DI int opaque_zero() { int z; asm volatile("v_mov_b32 %0, 0" : "=v"(z)); return z; }
template <int CTRL> DI float dpp_mov(float x) { return __builtin_bit_cast(float, __builtin_amdgcn_update_dpp(0, __builtin_bit_cast(int, x), CTRL, 0xf, 0xf, true)); }
DI float row16_sum(float q) {
    q += dpp_mov<0xB1>(q); q += dpp_mov<0x4E>(q); q += dpp_mov<0x128>(q); q += dpp_mov<0x124>(q); return q;
}
DI int perm_pos(int c32) { return ((c32 >> 2) & 3) * 8 + (c32 >> 4) * 4 + (c32 & 3); }

DI void transpose_item(const float* W, int Nsrc, int nvalid, const float* g, bf16_t* WT, int kb, int nb, float* tile, int tid) {
    const int k0 = kb * 64, n0 = nb * 64;
    {
        const int nn = tid & 63, kk0 = tid >> 6;
#pragma unroll
        for (int i = 0; i < 8; ++i) {
            const int kk = kk0 + 8 * i;
            float v = 0.f;
            if (n0 + nn < nvalid) v = W[(size_t)(k0 + kk) * Nsrc + n0 + nn];
            if (g) v *= g[k0 + kk];
            tile[kk * 65 + nn] = v;
        }
    }
    __syncthreads();
    {
        const int n = tid >> 3, c = tid & 7;
        const float* s = tile + (8 * c) * 65 + n;
        u32x4 o; o.x = pk2(s[0], s[65]); o.y = pk2(s[2 * 65], s[3 * 65]); o.z = pk2(s[4 * 65], s[5 * 65]); o.w = pk2(s[6 * 65], s[7 * 65]);
        *(u32x4*)(WT + (size_t)(n0 + n) * DM + k0 + 8 * c) = o;
    }
    __syncthreads();
}

DI void phase0(const Params& p, unsigned char* smem, const int tid) {
    const int wid = tid >> 6, lane = tid & 63;
    float* tile = (float*)smem;
    constexpr int I_IN = 4 * 16 * 56, I_OUT = 4 * 16 * 16, I_X = MT / 8;
    for (int it = blockIdx.x; it < I_IN + I_OUT + I_X; it += gridDim.x) {
        if (it < I_IN) {
            const int l = it / (16 * 56), r = it % (16 * 56), kb = r / 56, nb = r % 56;
            transpose_item(p.w_in + (size_t)l * DM * NIN, NIN, NIN, p.norm_g + l * DM, (bf16_t*)(p.ws + W_WINT) + (size_t)l * NPAD * DM, kb, nb, tile, tid);
        } else if (it < I_IN + I_OUT) {
            const int r0 = it - I_IN, l = r0 / 256, r = r0 % 256, kb = r / 16, nb = r % 16;
            transpose_item(p.w_out + (size_t)l * DM * DM, DM, DM, nullptr, (bf16_t*)(p.ws + W_WOUTT) + (size_t)l * DM * DM, kb, nb, tile, tid);
        } else {
            const int row = (it - I_IN - I_OUT) * 8 + wid;
            const float* src = row < MP ? p.x_prompt + (size_t)row * DM : p.x_sample + (size_t)(row - MP) * DM;
            bf16_t* dst = (bf16_t*)(p.ws + W_XB) + (size_t)row * DM;
            float s = 0.f;
#pragma unroll
            for (int j = 0; j < 4; ++j) {
                const f32x4 v = *(const f32x4*)(src + (lane + 64 * j) * 4);
                s += v[0] * v[0] + v[1] * v[1] + v[2] * v[2] + v[3] * v[3];
                u32x2 o; o.x = pk2(v[0], v[1]); o.y = pk2(v[2], v[3]);
                *(u32x2*)(dst + (lane + 64 * j) * 4) = o;
            }
            s = wave_sum(s);
            float* ss = (float*)(p.ws + W_SS);
            if (lane == 0) { ss[row] = s; ss[MT + row] = 0.f; ss[2 * MT + row] = 0.f; ss[3 * MT + row] = 0.f; }
        }
    }
}

struct EpiIn {
    static constexpr bool PERM = true, AFTER_DRAIN = false;
    bf16_t* Z; float* z8; const float* ss;
    DI void operator()(const f32x4 (&acc)[2][2][4][2], const pg8::Unit& u, int wr, int wc, int fr, int fq) const {
        const int row0 = u.pm * 256 + wr * 64 + fr;
#pragma unroll
        for (int ai = 0; ai < 2; ++ai)
#pragma unroll
            for (int m = 0; m < 4; ++m) {
                const int row = row0 + ai * 128 + m * 16;
                const float rstd = rsqrtf(ss[row] * (1.0f / DM) + EPSF);
                if (u.pn < 13) {
                    bf16_t* rowp = Z + (size_t)row * ZS + u.pn * 256 + wc * 32 + 8 * fq;
#pragma unroll
                    for (int bj = 0; bj < 2; ++bj) {
                        const f32x4 v0 = acc[ai][bj][m][0] * rstd, v1 = acc[ai][bj][m][1] * rstd;
                        u32x4 w; w.x = cvt_pk_bf16(v0[0], v0[1]); w.y = cvt_pk_bf16(v0[2], v0[3]); w.z = cvt_pk_bf16(v1[0], v1[1]); w.w = cvt_pk_bf16(v1[2], v1[3]);
                        *(u32x4*)(rowp + bj * 128) = w;
                    }
                } else if (wc == 0 && fq == 0) {
                    *(f32x4*)(z8 + (size_t)row * 8) = acc[ai][0][m][0] * rstd;
                    *(f32x4*)(z8 + (size_t)row * 8 + 4) = acc[ai][0][m][1] * rstd;
                }
            }
    }
};
struct EpiOut {
    static constexpr bool PERM = false, AFTER_DRAIN = false;
    const float* xin_p; const float* xin_s; float* xout; bf16_t* xb; float* ssn;
    DI void operator()(const f32x4 (&acc)[2][2][4][2], const pg8::Unit& u, int wr, int wc, int fr, int fq) const {
        const int row0 = u.pm * 256 + wr * 64 + fr, col0 = u.pn * 256 + wc * 32 + 4 * fq;
#pragma unroll
        for (int ai = 0; ai < 2; ++ai)
#pragma unroll
            for (int m = 0; m < 4; ++m) {
                const int row = row0 + ai * 128 + m * 16;
                const float* src = (row < MP ? xin_p + (size_t)row * DM : xin_s + (size_t)(row - MP) * DM) + col0;
                float* dst = xout + (size_t)row * DM + col0;
                bf16_t* dstb = xb + (size_t)row * DM + col0;
                float sq = 0.f;
#pragma unroll
                for (int bj = 0; bj < 2; ++bj)
#pragma unroll
                    for (int n = 0; n < 2; ++n) {
                        const f32x4 v = *(const f32x4*)(src + bj * 128 + n * 16) + acc[ai][bj][m][n];
                        *(f32x4*)(dst + bj * 128 + n * 16) = v;
                        if (ssn) {
                            u32x2 o; o.x = cvt_pk_bf16(v[0], v[1]); o.y = cvt_pk_bf16(v[2], v[3]);
                            *(u32x2*)(dstb + bj * 128 + n * 16) = o;
                            sq += v[0] * v[0] + v[1] * v[1] + v[2] * v[2] + v[3] * v[3];
                        }
                    }
                if (ssn) {
                    sq += __shfl_xor(sq, 16); sq += __shfl_xor(sq, 32);
                    if (fq == 0) atomicAdd(ssn + row, sq);
                }
                asm volatile("" ::: "memory");
            }
    }
};

constexpr int PL_G = 0, PL_BETA = 256, PL_EG = 512, PL_K = 1024, PL_Q = PL_K + 64 * 272, PL_RHS = PL_Q + 64 * 272, PL_A = PL_RHS + 64 * 256 * 4,
              PL_AQK = PL_A + 64 * 64 * 4, PL_KDT = PL_AQK + 64 * 72 * 2, PL_END = PL_KDT + 128 * 72 * 2;
static_assert(PL_END <= LDS_BYTES, "prep LDS");

DI u32x4 perm_chunk_bf16(const bf16_t* row, int s, int g) {
    const u32x2 a = *(const u32x2*)(row + 32 * s + 4 * g), b = *(const u32x2*)(row + 32 * s + 16 + 4 * g);
    u32x4 o; o.x = a.x; o.y = a.y; o.z = b.x; o.w = b.y; return o;
}

DI void prep_item(const Params& p, int l, int item, unsigned char* smem, const int tid) {
    const int wid = tid >> 6, lane = tid & 63;
    const int h = item & 3, n = (item >> 2) & 127, b = item >> 9;
    const int R0 = b * 8192 + n * 64;
    float* sG = (float*)(smem + PL_G); float* sBeta = (float*)(smem + PL_BETA); float* sEG = (float*)(smem + PL_EG);
    bf16_t* sK = (bf16_t*)(smem + PL_K); bf16_t* sQ = (bf16_t*)(smem + PL_Q);
    float* sRhs = (float*)(smem + PL_RHS); float* sA = (float*)(smem + PL_A);
    bf16_t* sAqk = (bf16_t*)(smem + PL_AQK); bf16_t* sKdT = (bf16_t*)(smem + PL_KDT);
    const bf16_t* Z = (const bf16_t*)(p.ws + W_Z);
    const float* z8 = (const float*)(p.ws + W_Z8);
    if (wid == 0) {
        const float db = z8[(size_t)(R0 + lane) * 8 + h], da = z8[(size_t)(R0 + lane) * 8 + 4 + h];
        const float beta = sigmoidf_(db);
        const float gg = -expf(p.a_log[l * 4 + h]) * softplusf_(da + p.dt_bias[l * 4 + h]);
        float G = gg;
#pragma unroll
        for (int o = 1; o < 64; o <<= 1) { const float t = __shfl_up(G, o); if (lane >= o) G += t; }
        sG[lane] = G; sBeta[lane] = beta; sEG[lane] = expf(G);
        if (lane == 63) ((float*)(p.ws + W_PGL))[item] = expf(G);
    }
    __syncthreads();
    const int z0 = opaque_zero();
    const float G63 = sG[63 + z0];
    {
        bf16_t* Qg = (bf16_t*)(p.ws + W_PQG) + (size_t)item * 8192;
        const int c = 2 * lane;
#pragma unroll 1
        for (int part = 0; part < 3; ++part) {
            const int ch = part * 512 + h * 128 + c;
            float cw0[4], cw1[4];
#pragma unroll
            for (int j = 0; j < 4; ++j) { cw0[j] = p.conv_w[(size_t)(l * 4 + j) * 1536 + ch]; cw1[j] = p.conv_w[(size_t)(l * 4 + j) * 1536 + ch + 1]; }
            float x0[11], x1[11];
#pragma unroll
            for (int i = 0; i < 11; ++i) {
                const int r = 8 * wid - 3 + i;
                unsigned w = 0u;
                if (n * 64 + r >= 0) w = *(const unsigned*)(Z + (size_t)(R0 + r) * ZS + C_DQKV + ch);
                x0[i] = lo16(w); x1[i] = hi16(w);
            }
#pragma unroll
            for (int tl = 0; tl < 8; ++tl) {
                const int t = 8 * wid + tl;
                float y0 = 0.f, y1 = 0.f;
#pragma unroll
                for (int j = 0; j < 4; ++j) { y0 += x0[tl + j] * cw0[j]; y1 += x1[tl + j] * cw1[j]; }
                y0 = siluf(y0); y1 = siluf(y1);
                if (part == 2) {
                    const float bt = sBeta[t + z0];
                    sRhs[t * 256 + c] = y0 * bt; sRhs[t * 256 + c + 1] = y1 * bt;
                } else {
                    const float ssq = wave_sum(y0 * y0 + y1 * y1);
                    float sc = rsqrtf(ssq + EPSF);
                    if (part == 0) {
                        sc *= 0.08838834764831845f;
                        y0 *= sc; y1 *= sc;
                        *(unsigned*)(sQ + t * 136 + c) = pk2(y0, y1);
                        const float eg = sEG[t + z0];
                        *(unsigned*)(Qg + t * 128 + (c & ~31) + perm_pos(c & 31)) = pk2(y0 * eg, y1 * eg);
                    } else {
                        y0 *= sc; y1 *= sc;
                        *(unsigned*)(sK + t * 136 + c) = pk2(y0, y1);
                        const float be = sBeta[t + z0] * sEG[t + z0];
                        sRhs[t * 256 + 128 + c] = y0 * be; sRhs[t * 256 + 128 + c + 1] = y1 * be;
                        const float kd = expf(G63 - sG[t + z0]);
                        sKdT[c * 72 + t] = f2bf(y0 * kd); sKdT[(c + 1) * 72 + t] = f2bf(y1 * kd);
                    }
                }
            }
        }
        if (n == 127 && tid < 384) {
            const int part = tid >> 7, cc = tid & 127, ch = part * 512 + h * 128 + cc;
#pragma unroll
            for (int r = 0; r < 3; ++r)
                p.out[O_PCONV + ((size_t)(l * 2 + b) * 3 + r) * 1536 + ch] = bf2f(Z[(size_t)(b * 8192 + 8189 + r) * ZS + C_DQKV + ch]);
        }
    }
    __syncthreads();
    {
        const int mat = wid >> 2, ti = wid & 3, fr = lane & 15, fq = lane >> 4;
        const bf16_t* Arows = mat ? sQ : sK;
        bf16x8 af[4];
#pragma unroll
        for (int ks = 0; ks < 4; ++ks) af[ks] = *(const bf16x8*)(Arows + (16 * ti + fr) * 136 + ks * 32 + fq * 8);
        float Gi[4], bi[4];
#pragma unroll
        for (int e = 0; e < 4; ++e) { Gi[e] = sG[16 * ti + 4 * fq + e]; bi[e] = sBeta[16 * ti + 4 * fq + e]; }
#pragma unroll
        for (int tj = 0; tj < 4; ++tj) {
            f32x4 acc = {0.f, 0.f, 0.f, 0.f};
            if (tj <= ti) {
#pragma unroll
                for (int ks = 0; ks < 4; ++ks) {
                    const bf16x8 bfr = *(const bf16x8*)(sK + (16 * tj + fr) * 136 + ks * 32 + fq * 8);
                    acc = __builtin_amdgcn_mfma_f32_16x16x32_bf16(af[ks], bfr, acc, 0, 0, 0);
                }
            }
            const int j = 16 * tj + fr; const float Gj = sG[j];
#pragma unroll
            for (int e = 0; e < 4; ++e) {
                const int i = 16 * ti + 4 * fq + e;
                if (mat == 0) {
                    sA[i * 64 + j] = (i > j) ? acc[e] * bi[e] * expf(Gi[e] - Gj) : 0.f;
                } else {
                    sAqk[i * 72 + j] = (i >= j) ? f2bf(acc[e] * expf(Gi[e] - Gj)) : (bf16_t)0;
                }
            }
        }
    }
    __syncthreads();
#ifndef NO_SOLVE
    if (tid < 256) {
        float sol[64];
        float* col = sRhs + tid;
        const float* sAz = sA + opaque_zero();
#pragma unroll
        for (int i = 0; i < 64; ++i) {
            float a = col[i * 256];
#pragma unroll
            for (int j4 = 0; j4 < (i + 3) / 4; ++j4) {
                const f32x4 av = *(const f32x4*)(sAz + i * 64 + 4 * j4);
#pragma unroll
                for (int e = 0; e < 4; ++e) if (4 * j4 + e < i) a -= av[e] * sol[4 * j4 + e];
            }
            sol[i] = a; col[i * 256] = a;
            asm volatile("" ::: "memory");
        }
    }
#endif
    __syncthreads();
    {
        float* U = (float*)(p.ws + W_PU) + (size_t)item * 8192;
        bf16_t* Gt = (bf16_t*)(p.ws + W_PG) + (size_t)item * 8192;
#pragma unroll
        for (int i = 0; i < 4; ++i) {
            const int q = tid + 512 * i, c = q & 127, tf = q >> 7, t = tf >> 2, fq = tf & 3;
            const int di = (((c >> 4) * 64 + fq * 16 + (c & 15)) * 16 + t * 4);
            f32x4 uv; float gv[4];
            const float gd = p.dn_norm_g[l * 128 + c];
#pragma unroll
            for (int e = 0; e < 4; ++e) {
                uv[e] = sRhs[(16 * t + 4 * fq + e) * 256 + c];
                gv[e] = siluf(bf2f(Z[(size_t)(R0 + 16 * t + 4 * fq + e) * ZS + C_DG + h * 128 + c])) * gd;
            }
            *(f32x4*)(U + di) = uv;
            u32x2 gw; gw.x = pk2(gv[0], gv[1]); gw.y = pk2(gv[2], gv[3]);
            *(u32x2*)(Gt + di) = gw;
        }
        bf16_t* Wn = (bf16_t*)(p.ws + W_PW) + (size_t)item * 8192;
#pragma unroll
        for (int i = 0; i < 2; ++i) {
            const int q = tid + 512 * i, r = q >> 4, c16 = q & 15, s = c16 >> 2, g = c16 & 3;
            const f32x4 a = *(const f32x4*)(sRhs + r * 256 + 128 + 32 * s + 4 * g), bb = *(const f32x4*)(sRhs + r * 256 + 128 + 32 * s + 16 + 4 * g);
            u32x4 o; o.x = pk2(-a[0], -a[1]); o.y = pk2(-a[2], -a[3]); o.z = pk2(-bb[0], -bb[1]); o.w = pk2(-bb[2], -bb[3]);
            *(u32x4*)(Wn + r * 128 + 32 * s + 8 * g) = o;
        }
        bf16_t* Aq = (bf16_t*)(p.ws + W_PAQK) + (size_t)item * 4096;
        { const int r = tid >> 3, c8 = tid & 7, s = c8 >> 2, g = c8 & 3; *(u32x4*)(Aq + r * 64 + 32 * s + 8 * g) = perm_chunk_bf16(sAqk + r * 72, s, g); }
        bf16_t* Kd = (bf16_t*)(p.ws + W_PKD) + (size_t)item * 8192;
#pragma unroll
        for (int i = 0; i < 2; ++i) { const int q = tid + 512 * i, r = q >> 3, c8 = q & 7, s = c8 >> 2, g = c8 & 3; *(u32x4*)(Kd + r * 64 + 32 * s + 8 * g) = perm_chunk_bf16(sKdT + r * 72, s, g); }
    }
    __syncthreads();
}

DI void sdelta_item(const Params& p, int l, int item, unsigned char* smem, const int tid) {
    const int wid = tid >> 6, lane = tid & 63;
    const int h = item & 3, b = item >> 2;
    float* sY = (float*)smem;
    float* sRed = sY + 3 * 4 * 128;
    float* sBG = sRed + 4 * 2 * 4 * 128;
    const bf16_t* Z = (const bf16_t*)(p.ws + W_Z);
    const float* z8 = (const float*)(p.ws + W_Z8);
    const int RS = MP + b * 4;
    if (tid < 384) {
        const int part = tid >> 7, c = tid & 127, ch = part * 512 + h * 128 + c;
        float xx[7];
#pragma unroll
        for (int r = 0; r < 3; ++r) xx[r] = p.state_conv[((size_t)(l * 128 + b) * 3 + r) * 1536 + ch];
#pragma unroll
        for (int t = 0; t < 4; ++t) xx[3 + t] = bf2f(Z[(size_t)(RS + t) * ZS + C_DQKV + ch]);
#pragma unroll
        for (int r = 0; r < 3; ++r) p.out[O_SCONV + ((size_t)(l * 128 + b) * 3 + r) * 1536 + ch] = xx[4 + r];
        float cw[4];
#pragma unroll
        for (int j = 0; j < 4; ++j) cw[j] = p.conv_w[(size_t)(l * 4 + j) * 1536 + ch];
#pragma unroll
        for (int t = 0; t < 4; ++t) {
            float y = 0.f;
#pragma unroll
            for (int j = 0; j < 4; ++j) y += xx[t + j] * cw[j];
            sY[(part * 4 + t) * 128 + c] = siluf(y);
        }
    } else if (tid < 388) {
        const int t = tid - 384;
        const float db = z8[(size_t)(RS + t) * 8 + h], da = z8[(size_t)(RS + t) * 8 + 4 + h];
        sBG[t] = sigmoidf_(db);
        sBG[4 + t] = expf(-expf(p.a_log[l * 4 + h]) * softplusf_(da + p.dt_bias[l * 4 + h]));
    }
    __syncthreads();
    {
        float* row = sY + wid * 128;
        const float a0 = row[lane], a1 = row[lane + 64];
        float sc = rsqrtf(wave_sum(a0 * a0 + a1 * a1) + EPSF);
        if (wid < 4) sc *= 0.08838834764831845f;
        row[lane] = a0 * sc; row[lane + 64] = a1 * sc;
    }
    __syncthreads();
    const int v = tid & 127, kq = tid >> 7;
    float S[32];
    const float* S0 = p.state_delta + ((size_t)(l * 128 + b) * 4 + h) * 16384;
#pragma unroll
    for (int i = 0; i < 32; ++i) S[i] = S0[(size_t)(kq * 32 + i) * 128 + v];
#pragma unroll 1
    for (int t = 0; t < 4; ++t) {
        const float a = sBG[4 + t], beta = sBG[t];
        const float* qv = sY + (0 * 4 + t) * 128 + kq * 32; const float* kv = sY + (1 * 4 + t) * 128 + kq * 32;
        float part = 0.f;
#pragma unroll
        for (int i = 0; i < 32; ++i) { S[i] *= a; part += kv[i] * S[i]; }
        float* red = sRed + (t * 2 + 0) * 512;
        red[kq * 128 + v] = part;
        __syncthreads();
        const float kS = red[v] + red[128 + v] + red[256 + v] + red[384 + v];
        const float vnew = (sY[(2 * 4 + t) * 128 + v] - kS) * beta;
        float po = 0.f;
#pragma unroll
        for (int i = 0; i < 32; ++i) { S[i] += kv[i] * vnew; po += qv[i] * S[i]; }
        float* red2 = sRed + (t * 2 + 1) * 512;
        red2[kq * 128 + v] = po;
    }
    __syncthreads();
    float* Sout = p.out + O_SDELTA + ((size_t)(l * 128 + b) * 4 + h) * 16384;
#pragma unroll
    for (int i = 0; i < 32; ++i) Sout[(size_t)(kq * 32 + i) * 128 + v] = S[i];
    if (wid < 4) {
        const int t = wid;
        const float* red2 = sRed + (t * 2 + 1) * 512;
        float o0 = red2[lane] + red2[128 + lane] + red2[256 + lane] + red2[384 + lane];
        float o1 = red2[lane + 64] + red2[128 + lane + 64] + red2[256 + lane + 64] + red2[384 + lane + 64];
        const float rstd = rsqrtf(wave_sum(o0 * o0 + o1 * o1) * (1.0f / 128.f) + EPSF);
        const bf16_t* dg = Z + (size_t)(RS + t) * ZS + C_DG + h * 128;
        bf16_t* mix = (bf16_t*)(p.ws + W_MIX) + (size_t)(RS + t) * DM + 512 + h * 128;
        mix[lane] = f2bf(o0 * rstd * p.dn_norm_g[l * 128 + lane] * siluf(bf2f(dg[lane])));
        mix[lane + 64] = f2bf(o1 * rstd * p.dn_norm_g[l * 128 + lane + 64] * siluf(bf2f(dg[lane + 64])));
    }
    __syncthreads();
}

DI void sattn_item(const Params& p, int l, int item, unsigned char* smem, const int tid) {
    const int wid = tid >> 6, lane = tid & 63;
    const int kvh = item & 1, b = item >> 1;
    float* sK = (float*)smem;
    float* sV = sK + 132 * 65;
    float* sQ = sV + 132 * 64;
    float* sP = sQ + 16 * 64;
    const bf16_t* Z = (const bf16_t*)(p.ws + W_Z);
    const int RS = MP + b * 4;
    const float* ck = p.cache_k + (size_t)(l * 128 + b) * 128 * 128 + kvh * 64;
    const float* cv = p.cache_v + (size_t)(l * 128 + b) * 128 * 128 + kvh * 64;
    float* ok = p.out + O_SWK + (size_t)(l * 128 + b) * 128 * 128 + kvh * 64;
    float* ov = p.out + O_SWV + (size_t)(l * 128 + b) * 128 * 128 + kvh * 64;
    for (int q = tid; q < 128 * 16; q += 512) {
        const int i = q >> 4, d4 = (q & 15) * 4;
        const f32x4 kk = *(const f32x4*)(ck + (size_t)i * 128 + d4), vv = *(const f32x4*)(cv + (size_t)i * 128 + d4);
        sK[i * 65 + d4] = kk[0]; sK[i * 65 + d4 + 1] = kk[1]; sK[i * 65 + d4 + 2] = kk[2]; sK[i * 65 + d4 + 3] = kk[3];
        *(f32x4*)(sV + i * 64 + d4) = vv;
        if (i >= 4) { *(f32x4*)(ok + (size_t)(i - 4) * 128 + d4) = kk; *(f32x4*)(ov + (size_t)(i - 4) * 128 + d4) = vv; }
    }
    for (int r = wid; r < 24; r += 8) {
        if (r >= 4 && r < 8) {
            const int t = r - 4;
            const float x = bf2f(Z[(size_t)(RS + t) * ZS + C_AV + kvh * 64 + lane]);
            sV[(128 + t) * 64 + lane] = x; ov[(size_t)(124 + t) * 128 + lane] = x;
        } else {
            const bool isk = r < 4; const int t = isk ? r : (r - 8) >> 2, hh = isk ? 0 : (r - 8) & 3;
            const float x = bf2f(Z[(size_t)(RS + t) * ZS + (isk ? C_AK + kvh * 64 : C_AQ + (kvh * 4 + hh) * 64) + lane]);
            const float rstd = rsqrtf(wave_sum(x * x) * (1.0f / 64.f) + EPSF);
            float y = x * rstd * (isk ? p.k_norm_g[l * 64 + lane] : p.q_norm_g[l * 64 + lane]);
            const float yp = __shfl_xor(y, 8);
            if (lane < 16) {
                const float ang = (float)(8192 + t) * rope_inv(lane & 7);
                float cs, sn; sincos_rev(ang, sn, cs);
                y = lane < 8 ? y * cs - yp * sn : y * cs + yp * sn;
            }
            if (isk) { sK[(128 + t) * 65 + lane] = y; ok[(size_t)(124 + t) * 128 + lane] = y; }
            else sQ[(t * 4 + hh) * 64 + lane] = y;
        }
    }
    __syncthreads();
    for (int q = tid; q < 16 * 132; q += 512) {
        const int r = q / 132, key = q % 132, t = r >> 2;
        float s = 0.f;
#pragma unroll 16
        for (int d = 0; d < 64; ++d) s += sQ[r * 64 + d] * sK[key * 65 + d];
        const bool valid = key < 128 ? (key >= t + 1) : (key - 128 <= t);
        sP[r * 136 + key] = valid ? s * 0.125f : -INFINITY;
    }
    __syncthreads();
    for (int r = wid; r < 16; r += 8) {
        const float sink = p.sinks[l * 8 + kvh * 4 + (r & 3)];
        const float s0 = sP[r * 136 + lane], s1 = sP[r * 136 + lane + 64], s2 = lane < 4 ? sP[r * 136 + lane + 128] : -INFINITY;
        const float m = fmaxf(wave_max(fmaxf(fmaxf(s0, s1), s2)), sink);
        const float p0 = __expf(s0 - m), p1 = __expf(s1 - m), p2 = lane < 4 ? __expf(s2 - m) : 0.f;
        const float den = wave_sum(p0 + p1 + p2) + __expf(sink - m);
        const float inv = 1.0f / den;
        sP[r * 136 + lane] = p0 * inv; sP[r * 136 + lane + 64] = p1 * inv; if (lane < 4) sP[r * 136 + lane + 128] = p2 * inv;
    }
    __syncthreads();
    for (int q = tid; q < 16 * 64; q += 512) {
        const int r = q >> 6, d = q & 63, t = r >> 2, hh = r & 3;
        float o = 0.f;
#pragma unroll 4
        for (int key = 0; key < 132; ++key) o += sP[r * 136 + key] * sV[key * 64 + d];
        const int colx = (kvh * 4 + hh) * 64 + d;
        const float ag = bf2f(Z[(size_t)(RS + t) * ZS + C_AG + colx]);
        ((bf16_t*)(p.ws + W_MIX))[(size_t)(RS + t) * DM + colx] = f2bf(o * siluf(ag));
    }
    __syncthreads();
}

constexpr int AL_Q = 0, AL_K = AL_Q + 4 * 64 * 144, AL_VT = AL_K + 192 * 144, AL_END = AL_VT + 64 * 400;
static_assert(AL_END <= LDS_BYTES, "attn LDS");
DI void pattn_item(const Params& p, int l, int item, unsigned char* smem, const int tid) {
    const int wid = tid >> 6, lane = tid & 63;
    const int kvh = item & 1, qb = (item >> 1) & 127, b = item >> 8;
    const int q0 = qb * 64;
    bf16_t* sQ = (bf16_t*)(smem + AL_Q); bf16_t* sK = (bf16_t*)(smem + AL_K); bf16_t* sVt = (bf16_t*)(smem + AL_VT);
    const bf16_t* Z = (const bf16_t*)(p.ws + W_Z);
    const bool last = (qb == 127);
    if (tid < 448) {
        const bool isq = tid < 256;
        const int qi = tid >> 2, hh = tid & 3, j = tid - 256;
        const int pos = isq ? q0 + qi : q0 - 128 + j;
        bf16_t* dst = isq ? sQ + (hh * 64 + qi) * 72 : sK + j * 72;
        if (pos >= 0) {
            const bf16_t* src = Z + (size_t)(b * 8192 + pos) * ZS + (isq ? C_AQ + (kvh * 4 + hh) * 64 : C_AK + kvh * 64);
            const float* gn = (isq ? p.q_norm_g + l * 64 : p.k_norm_g + l * 64) + opaque_zero();
            float x[64];
#pragma unroll
            for (int c = 0; c < 8; ++c) {
                const u32x4 w = *(const u32x4*)(src + 8 * c);
                x[8 * c] = lo16(w.x); x[8 * c + 1] = hi16(w.x); x[8 * c + 2] = lo16(w.y); x[8 * c + 3] = hi16(w.y);
                x[8 * c + 4] = lo16(w.z); x[8 * c + 5] = hi16(w.z); x[8 * c + 6] = lo16(w.w); x[8 * c + 7] = hi16(w.w);
            }
            float ss = 0.f;
#pragma unroll
            for (int d = 0; d < 64; ++d) ss += x[d] * x[d];
            const float rstd = rsqrtf(ss * (1.0f / 64.f) + EPSF);
#pragma unroll
            for (int c = 0; c < 8; ++c) {
#pragma unroll
                for (int e = 0; e < 8; ++e) x[8 * c + e] = x[8 * c + e] * rstd * gn[8 * c + e];
                asm volatile("" ::: "memory");
            }
#pragma unroll
            for (int i = 0; i < 8; ++i) {
                const float ang = (float)pos * rope_inv(i);
                float cs, sn; sincos_rev(ang, sn, cs);
                const float x1 = x[i], x2 = x[8 + i];
                x[i] = x1 * cs - x2 * sn; x[8 + i] = x2 * cs + x1 * sn;
            }
#pragma unroll
            for (int c = 0; c < 8; ++c) {
                u32x4 w; w.x = pk2(x[8 * c], x[8 * c + 1]); w.y = pk2(x[8 * c + 2], x[8 * c + 3]); w.z = pk2(x[8 * c + 4], x[8 * c + 5]); w.w = pk2(x[8 * c + 6], x[8 * c + 7]);
                *(u32x4*)(dst + 8 * c) = w;
            }
            if (!isq && last && j >= 64) {
                float* o = p.out + O_PWK + ((size_t)((l * 2 + b) * 128 + (j - 64)) * 2 + kvh) * 64;
#pragma unroll
                for (int c = 0; c < 16; ++c) { f32x4 v = {x[4 * c], x[4 * c + 1], x[4 * c + 2], x[4 * c + 3]}; *(f32x4*)(o + 4 * c) = v; }
            }
        } else {
            const u32x4 zz = {0u, 0u, 0u, 0u};
#pragma unroll
            for (int c = 0; c < 8; ++c) *(u32x4*)(dst + 8 * c) = zz;
        }
    }
    for (int q = tid; q < 192 * 8; q += 512) {
        const int j = q >> 3, d0 = (q & 7) * 8, pos = q0 - 128 + j;
        u32x4 w = {0u, 0u, 0u, 0u};
        if (pos >= 0) w = *(const u32x4*)(Z + (size_t)(b * 8192 + pos) * ZS + C_AV + kvh * 64 + d0);
        const int pj = (j & ~31) + perm_pos(j & 31);
        bf16_t* d = sVt + d0 * 200 + pj;
        d[0] = (bf16_t)(w.x & 0xffff); d[200] = (bf16_t)(w.x >> 16); d[400] = (bf16_t)(w.y & 0xffff); d[600] = (bf16_t)(w.y >> 16);
        d[800] = (bf16_t)(w.z & 0xffff); d[1000] = (bf16_t)(w.z >> 16); d[1200] = (bf16_t)(w.w & 0xffff); d[1400] = (bf16_t)(w.w >> 16);
        if (last && j >= 64) {
            float* o = p.out + O_PWV + ((size_t)((l * 2 + b) * 128 + (j - 64)) * 2 + kvh) * 64 + d0;
            f32x4 a = {lo16(w.x), hi16(w.x), lo16(w.y), hi16(w.y)}, c = {lo16(w.z), hi16(w.z), lo16(w.w), hi16(w.w)};
            *(f32x4*)o = a; *(f32x4*)(o + 4) = c;
        }
    }
    __syncthreads();
    {
        const int hh = wid >> 1, t0 = (wid & 1) * 32, fr = lane & 15, fq = lane >> 4;
        bf16x8 qf[2][2];
#pragma unroll
        for (int qt = 0; qt < 2; ++qt)
#pragma unroll
            for (int ks = 0; ks < 2; ++ks) qf[qt][ks] = *(const bf16x8*)(sQ + (hh * 64 + t0 + 16 * qt + fr) * 72 + ks * 32 + fq * 8);
        f32x4 s[10][2];
#pragma unroll
        for (int kt = 0; kt < 10; ++kt) {
            bf16x8 kf[2];
#pragma unroll
            for (int ks = 0; ks < 2; ++ks) kf[ks] = *(const bf16x8*)(sK + (t0 + 16 * kt + fr) * 72 + ks * 32 + fq * 8);
#pragma unroll
            for (int qt = 0; qt < 2; ++qt) {
                f32x4 a = {0.f, 0.f, 0.f, 0.f};
                a = __builtin_amdgcn_mfma_f32_16x16x32_bf16(kf[0], qf[qt][0], a, 0, 0, 0);
                a = __builtin_amdgcn_mfma_f32_16x16x32_bf16(kf[1], qf[qt][1], a, 0, 0, 0);
                s[kt][qt] = a;
            }
        }
        const float sink = p.sinks[l * 8 + kvh * 4 + hh];
        float inv[2];
#pragma unroll
        for (int qt = 0; qt < 2; ++qt) {
            const int t = t0 + 16 * qt + fr;
            float m = sink;
#pragma unroll
            for (int kt = 0; kt < 10; ++kt)
#pragma unroll
                for (int e = 0; e < 4; ++e) {
                    const int j = t0 + 16 * kt + 4 * fq + e;
                    const bool valid = (j >= t + 1) && (j <= t + 128) && (q0 - 128 + j >= 0);
                    const float v = valid ? s[kt][qt][e] * 0.125f : -INFINITY;
                    s[kt][qt][e] = v; m = fmaxf(m, v);
                }
            m = fmaxf(m, __shfl_xor(m, 16)); m = fmaxf(m, __shfl_xor(m, 32));
            float sum = 0.f;
#pragma unroll
            for (int kt = 0; kt < 10; ++kt)
#pragma unroll
                for (int e = 0; e < 4; ++e) { const float pv = __expf(s[kt][qt][e] - m); s[kt][qt][e] = pv; sum += pv; }
            sum += __shfl_xor(sum, 16); sum += __shfl_xor(sum, 32);
            inv[qt] = 1.0f / (sum + __expf(sink - m));
        }
        f32x4 o[4][2];
#pragma unroll
        for (int dt = 0; dt < 4; ++dt)
#pragma unroll
            for (int qt = 0; qt < 2; ++qt) o[dt][qt] = (f32x4){0.f, 0.f, 0.f, 0.f};
#pragma unroll
        for (int sp = 0; sp < 5; ++sp) {
            bf16x8 pf[2];
#pragma unroll
            for (int qt = 0; qt < 2; ++qt) {
                u32x4 w; w.x = cvt_pk_bf16(s[2 * sp][qt][0], s[2 * sp][qt][1]); w.y = cvt_pk_bf16(s[2 * sp][qt][2], s[2 * sp][qt][3]);
                w.z = cvt_pk_bf16(s[2 * sp + 1][qt][0], s[2 * sp + 1][qt][1]); w.w = cvt_pk_bf16(s[2 * sp + 1][qt][2], s[2 * sp + 1][qt][3]);
                pf[qt] = __builtin_bit_cast(bf16x8, w);
            }
#pragma unroll
            for (int dt = 0; dt < 4; ++dt) {
                const bf16x8 vf = *(const bf16x8*)(sVt + (16 * dt + fr) * 200 + t0 + 32 * sp + fq * 8);
#pragma unroll
                for (int qt = 0; qt < 2; ++qt) o[dt][qt] = __builtin_amdgcn_mfma_f32_16x16x32_bf16(vf, pf[qt], o[dt][qt], 0, 0, 0);
            }
        }
#pragma unroll
        for (int qt = 0; qt < 2; ++qt) {
            const size_t row = (size_t)(b * 8192 + q0 + t0 + 16 * qt + fr);
#pragma unroll
            for (int dt = 0; dt < 4; ++dt) {
                const int colx = (kvh * 4 + hh) * 64 + 16 * dt + 4 * fq;
                const u32x2 ag = *(const u32x2*)(Z + row * ZS + C_AG + colx);
                const f32x4 ov = o[dt][qt] * inv[qt];
                u32x2 w; w.x = pk2(ov[0] * siluf(lo16(ag.x)), ov[1] * siluf(hi16(ag.x))); w.y = pk2(ov[2] * siluf(lo16(ag.y)), ov[3] * siluf(hi16(ag.y)));
                *(u32x2*)((bf16_t*)(p.ws + W_MIX) + row * DM + colx) = w;
            }
        }
    }
    __syncthreads();
}

constexpr int SL_W = 0, SL_QG = 64 * 272, SL_KD = SL_QG + 64 * 272, SL_AQK = SL_KD + 128 * 144, SL_BUF = SL_AQK + 64 * 144, SL_SS = 2 * SL_BUF, SL_END = SL_SS + 2 * 64 * 8 * 4;
static_assert(SL_END <= LDS_BYTES, "scan LDS");
DI bf16x8 pack_b(const f32x4& a, const f32x4& b) {
    u32x4 w; w.x = cvt_pk_bf16(a[0], a[1]); w.y = cvt_pk_bf16(a[2], a[3]); w.z = cvt_pk_bf16(b[0], b[1]); w.w = cvt_pk_bf16(b[2], b[3]);
    return __builtin_bit_cast(bf16x8, w);
}
DI void scan_chain(const Params& p, int l, int bh, unsigned char* smem, const int tid) {
    const int wid = tid >> 6, lane = tid & 63, fr = lane & 15, fq = lane >> 4;
    const int b = bh >> 2, h = bh & 3, c0 = wid * 16;
    float* sSS = (float*)(smem + SL_SS);
    const unsigned char* gW = p.ws + W_PW; const unsigned char* gQ = p.ws + W_PQG; const unsigned char* gK = p.ws + W_PKD; const unsigned char* gA = p.ws + W_PAQK;
    const float* gU = (const float*)(p.ws + W_PU); const float* gGL = (const float*)(p.ws + W_PGL);
    const bf16_t* Z = (const bf16_t*)(p.ws + W_Z);
    bf16_t* MIX = (bf16_t*)(p.ws + W_MIX);
    const unsigned moff = (unsigned)((4 * fq) * DM + 512 + h * 128 + c0 + fr) * 2u;
    const bf16_t* gG = (const bf16_t*)(p.ws + W_PG);
    const int r16 = tid >> 4, c16 = tid & 15, r8 = tid >> 3, c8 = tid & 7;
    const int dW0 = SL_W + r16 * 272 + c16 * 16, dW1 = dW0 + 32 * 272, dQ0 = SL_QG + r16 * 272 + c16 * 16, dQ1 = dQ0 + 32 * 272;
    const int dK0 = SL_KD + r8 * 144 + c8 * 16, dK1 = dK0 + 64 * 144, dA0 = SL_AQK + r8 * 144 + c8 * 16;
    u32x4 st[7];
#define SCAN_LOAD(it_) do { const size_t i16 = (size_t)(it_) * 16384, i8 = (size_t)(it_) * 8192; \
        st[0] = *(const u32x4*)(gW + i16 + tid * 16); st[1] = *(const u32x4*)(gW + i16 + 8192 + tid * 16); \
        st[2] = *(const u32x4*)(gQ + i16 + tid * 16); st[3] = *(const u32x4*)(gQ + i16 + 8192 + tid * 16); \
        st[4] = *(const u32x4*)(gK + i16 + tid * 16); st[5] = *(const u32x4*)(gK + i16 + 8192 + tid * 16); \
        st[6] = *(const u32x4*)(gA + i8 + tid * 16); } while (0)
#define SCAN_STORE(bufp) do { unsigned char* bb_ = (bufp); \
        *(u32x4*)(bb_ + dW0) = st[0]; *(u32x4*)(bb_ + dW1) = st[1]; *(u32x4*)(bb_ + dQ0) = st[2]; *(u32x4*)(bb_ + dQ1) = st[3]; \
        *(u32x4*)(bb_ + dK0) = st[4]; *(u32x4*)(bb_ + dK1) = st[5]; *(u32x4*)(bb_ + dA0) = st[6]; } while (0)
    const int item0 = (b * 128) * 4 + h;
    SCAN_LOAD(item0);
    SCAN_STORE(smem);
    f32x4 S[8];
#pragma unroll
    for (int t = 0; t < 8; ++t) S[t] = (f32x4){0.f, 0.f, 0.f, 0.f};
    f32x4 un[4]; u32x4 dgn[2]; float gln = gGL[item0];
    const int lofs = (wid * 64 + lane) * 16;
    {
        const f32x4* up = (const f32x4*)(gU + (size_t)item0 * 8192 + lofs);
#pragma unroll
        for (int t = 0; t < 4; ++t) un[t] = up[t];
        const u32x4* gp = (const u32x4*)(gG + (size_t)item0 * 8192 + lofs);
        dgn[0] = gp[0]; dgn[1] = gp[1];
    }
    __syncthreads();
#pragma unroll 1
    for (int n = 0; n < 128; ++n) {
        const int item = item0 + 4 * n;
        const unsigned char* buf = smem + (n & 1) * SL_BUF;
        if (n + 1 < 128) SCAN_LOAD(item + 4);
        unsigned char* mixb = (unsigned char*)MIX + (size_t)(b * 8192 + n * 64) * (DM * 2);
        bf16x8 Sb[4];
#pragma unroll
        for (int s = 0; s < 4; ++s) Sb[s] = pack_b(S[2 * s], S[2 * s + 1]);
        f32x4 vn[4]; u32x4 dgc[2];
#pragma unroll
        for (int t = 0; t < 4; ++t) vn[t] = un[t];
        dgc[0] = dgn[0]; dgc[1] = dgn[1];
        const float gl = gln;
        if (n + 1 < 128) {
            const f32x4* up = (const f32x4*)(gU + (size_t)(item + 4) * 8192 + lofs);
#pragma unroll
            for (int t = 0; t < 4; ++t) un[t] = up[t];
            const u32x4* gp = (const u32x4*)(gG + (size_t)(item + 4) * 8192 + lofs);
            dgn[0] = gp[0]; dgn[1] = gp[1];
            gln = gGL[item + 4];
        }
        f32x4 o[4];
#pragma unroll
        for (int t = 0; t < 4; ++t) {
            o[t] = (f32x4){0.f, 0.f, 0.f, 0.f};
#pragma unroll
            for (int s = 0; s < 4; ++s) {
                const bf16x8 wf = *(const bf16x8*)(buf + SL_W + (16 * t + fr) * 272 + s * 64 + fq * 16);
                const bf16x8 qf = *(const bf16x8*)(buf + SL_QG + (16 * t + fr) * 272 + s * 64 + fq * 16);
                vn[t] = __builtin_amdgcn_mfma_f32_16x16x32_bf16(wf, Sb[s], vn[t], 0, 0, 0);
                o[t] = __builtin_amdgcn_mfma_f32_16x16x32_bf16(qf, Sb[s], o[t], 0, 0, 0);
            }
            asm volatile("" ::: "memory");
        }
        bf16x8 vb[2];
        vb[0] = pack_b(vn[0], vn[1]); vb[1] = pack_b(vn[2], vn[3]);
#pragma unroll
        for (int t = 0; t < 4; ++t)
#pragma unroll
            for (int s = 0; s < 2; ++s) {
                const bf16x8 af = *(const bf16x8*)(buf + SL_AQK + (16 * t + fr) * 144 + s * 64 + fq * 16);
                o[t] = __builtin_amdgcn_mfma_f32_16x16x32_bf16(af, vb[s], o[t], 0, 0, 0);
            }
        asm volatile("" ::: "memory");
#pragma unroll
        for (int t = 0; t < 8; ++t) {
            S[t] = S[t] * gl;
#pragma unroll
            for (int s = 0; s < 2; ++s) {
                const bf16x8 kf = *(const bf16x8*)(buf + SL_KD + (16 * t + fr) * 144 + s * 64 + fq * 16);
                S[t] = __builtin_amdgcn_mfma_f32_16x16x32_bf16(kf, vb[s], S[t], 0, 0, 0);
            }
            if (t & 1) asm volatile("" ::: "memory");
        }
        float* ssw = sSS + (n & 1) * 512;
#pragma unroll
        for (int t = 0; t < 4; ++t)
#pragma unroll
            for (int e = 0; e < 4; ++e) {
                const float q = row16_sum(o[t][e] * o[t][e]);
                if (fr == 0) ssw[(16 * t + 4 * fq + e) * 8 + wid] = q;
            }
        if (n + 1 < 128) SCAN_STORE(smem + ((n + 1) & 1) * SL_BUF);
        __syncthreads();
#pragma unroll
        for (int t = 0; t < 4; ++t)
#pragma unroll
            for (int e = 0; e < 4; ++e) {
                const int r = 16 * t + 4 * fq + e;
                const f32x4 a = *(const f32x4*)(ssw + r * 8), bq = *(const f32x4*)(ssw + r * 8 + 4);
                const float tot = (a[0] + a[1]) + (a[2] + a[3]) + (bq[0] + bq[1]) + (bq[2] + bq[3]);
                const float rstd = rsqrtf(tot * (1.0f / 128.f) + EPSF);
                const unsigned gw = dgc[t >> 1][(t & 1) * 2 + (e >> 1)];
                const float gate = (e & 1) ? hi16(gw) : lo16(gw);
                *(bf16_t*)(mixb + (moff + (unsigned)(16 * t + e) * 2048u)) = f2bf(o[t][e] * rstd * gate);
                asm volatile("" ::: "memory");
            }
    }
    float* Sout = p.out + O_PDELTA + ((size_t)(l * 2 + b) * 4 + h) * 16384;
#pragma unroll
    for (int t = 0; t < 8; ++t)
#pragma unroll
        for (int e = 0; e < 4; ++e) Sout[(size_t)(16 * t + 4 * fq + e) * 128 + c0 + fr] = S[t][e];
    __syncthreads();
#undef SCAN_LOAD
#undef SCAN_STORE
}

#ifndef PH_EN
#define PH_EN 255
#endif
__global__ void __launch_bounds__(512, 2) hybrid_fwd(Params p) {
    extern __shared__ __attribute__((aligned(16))) unsigned char smem[];
    for (int ph = p.phase_lo; ph < p.phase_hi; ++ph) {
        int tid = threadIdx.x; asm volatile("" : "+v"(tid));
        if (ph == 0) {
            if (PH_EN & 1) phase0(p, smem, tid);
        } else {
            const int l = (ph - 1) >> 2, k = (ph - 1) & 3;
            if (k == 0) {
                pg8::Gemm g; g.A = (const bf16_t*)(p.ws + W_XB); g.Bt = (const bf16_t*)(p.ws + W_WINT) + (size_t)l * NPAD * DM; g.M = MT; g.N = NPAD; g.K = DM;
                pg8::StaticOrder so; so.init(MT, NPAD, gridDim.x, blockIdx.x);
                EpiIn e; e.Z = (bf16_t*)(p.ws + W_Z); e.z8 = (float*)(p.ws + W_Z8); e.ss = (const float*)(p.ws + W_SS) + (size_t)l * MT;
                if (PH_EN & 2) pg8::gemm_phase<EpiIn, pg8::StaticOrder, false>((PG8_LAS unsigned char*)smem, g, so, e, nullptr, tid);
            } else if (k == 1) {
                for (int it = blockIdx.x; it < 1024 + 512 + 256; it += gridDim.x) {
                    asm volatile("" : "+v"(tid));
                    if (it < 1024) { if (PH_EN & 4) prep_item(p, l, it, smem, tid); }
                    else if (it < 1536) { if (PH_EN & 8) sdelta_item(p, l, it - 1024, smem, tid); }
                    else { if (PH_EN & 16) sattn_item(p, l, it - 1536, smem, tid); }
                }
            } else if (k == 2) {
                if (blockIdx.x < 8) { if (PH_EN & 32) scan_chain(p, l, blockIdx.x, smem, tid); }
                else for (int it = blockIdx.x - 8; it < 512; it += gridDim.x - 8) { asm volatile("" : "+v"(tid)); if (PH_EN & 64) pattn_item(p, l, it, smem, tid); }
            } else {
                pg8::Gemm g; g.A = (const bf16_t*)(p.ws + W_MIX); g.Bt = (const bf16_t*)(p.ws + W_WOUTT) + (size_t)l * DM * DM; g.M = MT; g.N = DM; g.K = DM;
                pg8::StaticOrder so; so.init(MT, DM, gridDim.x, blockIdx.x);
                EpiOut e; e.xin_p = l == 0 ? p.x_prompt : p.out + O_YP; e.xin_s = l == 0 ? p.x_sample : p.out + O_YS; e.xout = p.out;
                e.xb = (bf16_t*)(p.ws + W_XB); e.ssn = l < 3 ? (float*)(p.ws + W_SS) + (size_t)(l + 1) * MT : nullptr;
                if (PH_EN & 128) pg8::gemm_phase<EpiOut, pg8::StaticOrder, false>((PG8_LAS unsigned char*)smem, g, so, e, nullptr, tid);
            }
        }
        if (p.coop && ph + 1 < p.phase_hi) cg::this_grid().sync();
    }
}

#ifndef N_LAUNCH_MODE
#define N_LAUNCH_MODE 0
#endif
extern "C" void kernel_launch(void* const* d_in, const int* in_sizes, int n_in, void* d_out, int out_size, void* d_ws, size_t ws_size, hipStream_t stream) {
    static int grid = 0;
    if (grid == 0) {
        if (n_in != 16 || ws_size < W_END) { fprintf(stderr, "kernel_launch: unexpected n_in %d or ws %zu (< %zu)\n", n_in, ws_size, (size_t)W_END); grid = -1; return; }
        int dev = 0, cus = 0;
        hipGetDevice(&dev); hipDeviceGetAttribute(&cus, hipDeviceAttributeMultiprocessorCount, dev);
        if (hipFuncSetAttribute((const void*)hybrid_fwd, hipFuncAttributeMaxDynamicSharedMemorySize, LDS_BYTES) != hipSuccess) { fprintf(stderr, "hipFuncSetAttribute failed\n"); grid = -1; return; }
        int per_cu = 0;
        if (hipOccupancyMaxActiveBlocksPerMultiprocessor(&per_cu, (const void*)hybrid_fwd, 512, LDS_BYTES) != hipSuccess || per_cu < 1) fprintf(stderr, "occupancy query says %d\n", per_cu);
        (void)hipGetLastError();
        grid = cus > 0 ? cus : 256;
    }
    if (grid < 0) return;
    Params p{};
    p.x_prompt = (const float*)d_in[0]; p.x_sample = (const float*)d_in[1]; p.cache_k = (const float*)d_in[2]; p.cache_v = (const float*)d_in[3];
    p.state_conv = (const float*)d_in[4]; p.state_delta = (const float*)d_in[5]; p.norm_g = (const float*)d_in[6]; p.w_in = (const float*)d_in[7];
    p.q_norm_g = (const float*)d_in[8]; p.k_norm_g = (const float*)d_in[9]; p.sinks = (const float*)d_in[10]; p.conv_w = (const float*)d_in[11];
    p.a_log = (const float*)d_in[12]; p.dt_bias = (const float*)d_in[13]; p.dn_norm_g = (const float*)d_in[14]; p.w_out = (const float*)d_in[15];
    p.out = (float*)d_out; p.ws = (unsigned char*)d_ws;
#if N_LAUNCH_MODE == 1
    p.phase_lo = 0; p.phase_hi = 17; p.coop = 1;
    void* args[] = {&p};
    hipError_t e = hipLaunchCooperativeKernel((const void*)hybrid_fwd, dim3(grid), dim3(512), args, LDS_BYTES, stream);
    if (e != hipSuccess) fprintf(stderr, "cooperative launch failed: %s (grid %d)\n", hipGetErrorString(e), grid);
#else
    for (int ph = 0; ph < 17; ++ph) {
        p.phase_lo = ph; p.phase_hi = ph + 1; p.coop = 0;
        hipLaunchKernelGGL(hybrid_fwd, dim3(grid), dim3(512), LDS_BYTES, stream, p);
    }
#endif
}
```

```cpp
#include <hip/hip_runtime.h>
#include <hip/hip_cooperative_groups.h>
#include <cstdio>
#include <cstdint>
namespace cg = cooperative_groups;
#define DI __device__ __forceinline__
#define XB_TMO      128
#define XB_XCNT(j)  (256  + 64 * (j))
#define XB_XSUB(j)  (1280 + 64 * (j))
#define XB_XGEN(j)  (2304 + 64 * (j))
#define XB_TOP      3328
#define XB_TOPGEN   3392
#define XCD_BAR_WORDS 3456
#define XB_SPIN_CAP (1u << 18)
#define XB_LAS __attribute__((address_space(3)))

__device__ __forceinline__ unsigned xb_ld(unsigned* p)              { return __hip_atomic_load(p, __ATOMIC_RELAXED, __HIP_MEMORY_SCOPE_AGENT); }
__device__ __forceinline__ unsigned xb_add(unsigned* p, unsigned v) { return __hip_atomic_fetch_add(p, v, __ATOMIC_RELAXED, __HIP_MEMORY_SCOPE_AGENT); }
__device__ __forceinline__ unsigned xb_xcc_id() { return (unsigned)__builtin_amdgcn_s_getreg((3 << 11) | 20) & 0xFu; }
#define XB_SPIN(cond, bar) do { unsigned _sp = 0; while (cond) { __builtin_amdgcn_s_sleep(1); \
    if ((++_sp & 255u) == 0u) { if (xb_ld(&(bar)[XB_TMO])) break; if (_sp > XB_SPIN_CAP) { atomicAdd(&(bar)[XB_TMO], 1u); break; } } } } while (0)

struct XcdBarrier {
    unsigned* bar; unsigned x;
    volatile XB_LAS unsigned* st;
};

__device__ __forceinline__ XcdBarrier xcd_barrier_post(unsigned* bar, volatile XB_LAS unsigned* st) {
    XcdBarrier b; b.bar = bar; b.x = xb_xcc_id(); b.st = st;
    if (threadIdx.x == 0) (void)xb_add(&bar[XB_XCNT(b.x)], 1u);
    return b;
}
__device__ __forceinline__ void xcd_barrier_complete(unsigned* bar, unsigned x, unsigned& nloc, unsigned& nx) {
    const unsigned G = gridDim.x * gridDim.y * gridDim.z;
    unsigned sum, cnt, mine, sp = 0u;
    for (;;) {
        sum = 0u; cnt = 0u; mine = 0u;
#pragma unroll
        for (unsigned j = 0; j < 16; ++j) { const unsigned c = xb_ld(&bar[XB_XCNT(j)]); sum += c; cnt += (c > 0u) ? 1u : 0u; mine = (j == x) ? c : mine; }
        if (sum == G) break;
        __builtin_amdgcn_s_sleep(1);
        if ((++sp & 255u) == 0u) { if (xb_ld(&bar[XB_TMO])) break; if (sp > XB_SPIN_CAP) { atomicAdd(&bar[XB_TMO], 1u); break; } }
    }
    nloc = mine > 0u ? mine : 1u; nx = cnt > 0u ? cnt : 1u;
}

__device__ __forceinline__ void xcd_barrier(const XcdBarrier& b) {
    asm volatile("s_waitcnt vmcnt(0)" ::: "memory");
    __syncthreads();
    if (threadIdx.x == 0) {
        unsigned* bar = b.bar;
        __builtin_amdgcn_s_waitcnt(0);
        unsigned nloc = b.st[0], nx = b.st[1];
        if (nloc == 0u) { xcd_barrier_complete(bar, b.x, nloc, nx); b.st[0] = nloc; b.st[1] = nx; }
        const unsigned old = xb_add(&bar[XB_XSUB(b.x)], 1u);
        const unsigned gen = old / nloc;
        if (old + 1u == (gen + 1u) * nloc) {
            __builtin_amdgcn_fence(__ATOMIC_RELEASE, "agent");
            asm volatile("s_waitcnt vmcnt(0)" ::: "memory");
            const unsigned og = xb_add(&bar[XB_TOP], 1u);
            const unsigned tg = og / nx;
            if (og + 1u == (tg + 1u) * nx) xb_add(&bar[XB_TOPGEN], 1u);
            else XB_SPIN(xb_ld(&bar[XB_TOPGEN]) == tg, bar);
            __builtin_amdgcn_fence(__ATOMIC_ACQUIRE, "agent");
            xb_add(&bar[XB_XGEN(b.x)], 1u);
            asm volatile("s_waitcnt vmcnt(0)" ::: "memory");
        } else {
            XB_SPIN(xb_ld(&bar[XB_XGEN(b.x)]) == gen, bar);
            __builtin_amdgcn_fence(__ATOMIC_ACQUIRE, "agent");
            asm volatile("s_waitcnt vmcnt(0)" ::: "memory");
        }
    }
    __syncthreads();
}

namespace pg8 {
#define PG8_LAS __attribute__((address_space(3)))
typedef unsigned short bf16_t;
typedef short bf16x8 __attribute__((ext_vector_type(8)));
typedef float f32x4 __attribute__((ext_vector_type(4)));
typedef unsigned u32x4 __attribute__((ext_vector_type(4)));
constexpr int BM = 256, BK = 64, HALF = 128, HTB = HALF * BK * 2  , STAGE_BYTES = 8 * HTB, NXCD = 8, WGM = 8;

__host__ __device__ __forceinline__ int lds_byte(int r, int c) { const int st = (r >> 4) * 2 + (c >> 5), rr = r & 15, cc = c & 31, ob = rr * 64 + cc * 2; return st * 1024 + (ob ^ (((ob >> 9) & 1) << 5)); }
__host__ __device__ __forceinline__ void stage_rc(int b, int& R, int& C) { const int st = b / 1024, sb = b % 1024, swz = sb ^ (((sb >> 9) & 1) << 5); R = (st >> 1) * 16 + swz / 64; C = (st & 1) * 32 + (swz % 64) / 2; }
__host__ __device__ __forceinline__ int perm32(int rho) { const int n = rho >> 4, i = rho & 15; return 8 * (i >> 2) + 4 * n + (i & 3); }

struct Unit { int pm, pn; };
struct Gemm { const bf16_t* A; const bf16_t* Bt; int M, N, K, KL; };

struct StaticOrder {
    int nM, nN, nwg, G, c;
    __host__ __device__ void init(int M, int N, int G_, int c_) { nM = M / BM; nN = N / BM; nwg = nM * nN; G = G_; c = c_; }
    __host__ __device__ bool next(int i, Unit& u) const {
        const long L = (long)i * G + c; if (L >= nwg) return false;
        int wgid = (int)L; { const int q = nwg / NXCD, r = nwg % NXCD, xcd = wgid % NXCD, off = wgid / NXCD; wgid = (xcd < r ? xcd * (q + 1) : r * (q + 1) + (xcd - r) * q) + off; }
        const int nig = WGM * nN, gid = wgid / nig, fm = gid * WGM, gsz = (nM - fm) < WGM ? (nM - fm) : WGM;
        u.pm = fm + ((wgid % nig) % gsz); u.pn = (wgid % nig) / gsz; return true;
    }
    __device__ __forceinline__ void a_ready(const Unit&) const {}
    __device__ __forceinline__ void done(const Unit&) const {}
};
typedef __bf16 bf16x2_native __attribute__((ext_vector_type(2)));
typedef float f32x2_native __attribute__((ext_vector_type(2)));
__device__ __forceinline__ unsigned cvt_pk_bf16(float lo, float hi) { const f32x2_native v = {lo, hi}; return __builtin_bit_cast(unsigned, __builtin_convertvector(v, bf16x2_native)); }
template <class Epi, class Sched, bool STAMP = false>
__device__ __forceinline__ void gemm_phase(PG8_LAS unsigned char* lds, const Gemm g, const Sched& S, const Epi& E, unsigned long long* stamps, const int tid_in) {
    const int tid = tid_in, wid = __builtin_amdgcn_readfirstlane(tid >> 6), lane = tid & 63, wr = wid >> 2, wc = wid & 3, fr = lane & 15, fq = lane >> 4;
    const int K = g.K, nt = g.KL / BK;
    int ts_lo = 0, ts_hi = 0, nts = 0; const unsigned long long rt_entry = STAMP ? (unsigned long long)wall_clock64() : 0ull;
#define PG8_STAMP() do { if (STAMP && wid == 0 && nts < 64) { const unsigned long long _c = (unsigned long long)clock64(); \
        ts_lo = (lane == nts) ? (int)(unsigned)_c : ts_lo; ts_hi = (lane == nts) ? (int)(unsigned)(_c >> 32) : ts_hi; ++nts; } } while (0)
    PG8_STAMP();
    unsigned voffA[2], voffB[2];
#pragma unroll
    for (int i = 0; i < 2; ++i) { int R, C; stage_rc(tid * 16 + i * 8192, R, C); const int Rb = Epi::PERM ? ((R & ~31) + perm32(R & 31)) : R;
        voffA[i] = (unsigned)(R * K + C) * 2u; voffB[i] = (unsigned)(Rb * K + C) * 2u; }
    const size_t kstep = (size_t)(BK * 2);
    const size_t hstep = (size_t)HALF * K * 2;
    const size_t tstep = 2 * hstep;
    const unsigned ldsw = (unsigned)wid * 1024u;
    const int aoff = lds_byte(wr * 64 + fr, fq * 8), boff = lds_byte(wc * 32 + fr, fq * 8);
#define PG8_SA(b, h) (((b) * 2 + (h)) * HTB)
#define PG8_SB(b, h) ((4 + (b) * 2 + (h)) * HTB)
#define PG8_STAGE(bufoff, gbase, voff) do { _Pragma("unroll") for (int _i = 0; _i < 2; ++_i) \
        __builtin_amdgcn_global_load_lds((const unsigned*)((const char*)(gbase) + (voff)[_i]), (PG8_LAS unsigned*)(lds + (bufoff) + ldsw + _i * 8192), 16, 0, 0); } while (0)
#define PG8_LDA(dst, b, h) do { _Pragma("unroll") for (int m = 0; m < 4; ++m) _Pragma("unroll") for (int k = 0; k < 2; ++k) dst[m][k] = *(const PG8_LAS bf16x8*)(lds + PG8_SA(b, h) + aoff + m * 2048 + k * 1024); } while (0)
#define PG8_LDB(dst, b, h) do { _Pragma("unroll") for (int n = 0; n < 2; ++n) _Pragma("unroll") for (int k = 0; k < 2; ++k) dst[n][k] = *(const PG8_LAS bf16x8*)(lds + PG8_SB(b, h) + boff + n * 2048 + k * 1024); } while (0)
#define PG8_MMA(ai, bj, At, Bt) do { __builtin_amdgcn_s_setprio(1); _Pragma("unroll") for (int m = 0; m < 4; ++m) _Pragma("unroll") for (int n = 0; n < 2; ++n) _Pragma("unroll") for (int k = 0; k < 2; ++k) \
        acc[ai][bj][m][n] = __builtin_amdgcn_mfma_f32_16x16x32_bf16(Bt[n][k], At[m][k], acc[ai][bj][m][n], 0, 0, 0); __builtin_amdgcn_s_setprio(0); } while (0)
#define PG8_WAIT_V(n) asm volatile("s_waitcnt vmcnt(" #n ")" ::: "memory")
#define PG8_WAIT_L(n) asm volatile("s_waitcnt lgkmcnt(" #n ")" ::: "memory")
#define PG8_BAR __builtin_amdgcn_s_barrier()
#define PG8_SCHED __builtin_amdgcn_sched_barrier(0)
    Unit cur, nxt; int ui = 0;
    if (!S.next(0, cur)) return;
    f32x4 acc[2][2][4][2];
#pragma unroll
    for (int a = 0; a < 2; ++a)
#pragma unroll
        for (int b = 0; b < 2; ++b)
#pragma unroll
            for (int m = 0; m < 4; ++m)
#pragma unroll
                for (int n = 0; n < 2; ++n) acc[a][b][m][n] = (f32x4){0.f, 0.f, 0.f, 0.f};
    bf16x8 At[4][2], B0[2][2], B1[2][2];
    const char* cA = (const char*)g.A + (size_t)cur.pm * tstep; const char* cB = (const char*)g.Bt + (size_t)cur.pn * tstep;
    S.a_ready(cur);
    PG8_STAGE(PG8_SB(0, 0), cB, voffB); PG8_STAGE(PG8_SA(0, 0), cA, voffA); PG8_STAGE(PG8_SB(0, 1), cB + hstep, voffB); PG8_STAGE(PG8_SA(0, 1), cA + hstep, voffA);
    if (wr == 1) PG8_BAR;
    PG8_WAIT_V(4); PG8_BAR;
    PG8_STAGE(PG8_SB(1, 0), cB + kstep, voffB); PG8_STAGE(PG8_SA(1, 0), cA + kstep, voffA); PG8_STAGE(PG8_SB(1, 1), cB + hstep + kstep, voffB);
    PG8_WAIT_V(6); PG8_BAR;
    PG8_STAMP();
    for (;;) {
        const bool has_next = S.next(ui + 1, nxt);
        const char* nA = has_next ? (const char*)g.A + (size_t)nxt.pm * tstep : cA; const char* nB = has_next ? (const char*)g.Bt + (size_t)nxt.pn * tstep : cB;
        for (int t = 0; t < nt; t += 2) {
            const bool last = (t == nt - 2);
            const char* a1 = cA + (size_t)(t + 1) * kstep;
            const char* a2 = last ? nA : cA + (size_t)(t + 2) * kstep; const char* b2 = last ? nB : cB + (size_t)(t + 2) * kstep;
            const char* a3 = a2 + kstep; const char* b3 = b2 + kstep;
            if (last && has_next) S.a_ready(nxt);
            PG8_LDB(B0, 0, 0); PG8_SCHED; PG8_LDA(At, 0, 0); PG8_STAGE(PG8_SA(1, 1), a1 + hstep, voffA);
            PG8_WAIT_L(8); PG8_BAR; PG8_WAIT_L(0); PG8_MMA(0, 0, At, B0); PG8_BAR; PG8_SCHED;
            PG8_LDB(B1, 0, 1); PG8_STAGE(PG8_SB(0, 0), b2, voffB);
            PG8_BAR; PG8_WAIT_L(0); PG8_MMA(0, 1, At, B1); PG8_BAR;
            PG8_LDA(At, 0, 1); PG8_STAGE(PG8_SA(0, 0), a2, voffA);
            PG8_BAR; PG8_WAIT_L(0); PG8_MMA(1, 0, At, B0); PG8_BAR; PG8_SCHED;
            PG8_STAGE(PG8_SB(0, 1), b2 + hstep, voffB);
            PG8_WAIT_V(6); PG8_BAR; PG8_MMA(1, 1, At, B1); PG8_BAR;
            PG8_LDB(B0, 1, 0); PG8_SCHED; PG8_LDA(At, 1, 0); PG8_STAGE(PG8_SA(0, 1), a2 + hstep, voffA);
            PG8_WAIT_L(8); PG8_BAR; PG8_WAIT_L(0); PG8_MMA(0, 0, At, B0); PG8_BAR; PG8_SCHED;
            PG8_LDB(B1, 1, 1); PG8_STAGE(PG8_SB(1, 0), b3, voffB);
            PG8_BAR; PG8_WAIT_L(0); PG8_MMA(0, 1, At, B1); PG8_BAR;
            PG8_LDA(At, 1, 1); PG8_STAGE(PG8_SA(1, 0), a3, voffA);
            PG8_BAR; PG8_WAIT_L(0); PG8_MMA(1, 0, At, B0); PG8_BAR; PG8_SCHED;
            PG8_STAGE(PG8_SB(1, 1), b3 + hstep, voffB);
            PG8_WAIT_V(6); PG8_BAR; PG8_MMA(1, 1, At, B1); PG8_BAR;
        }
        PG8_STAMP();
        if constexpr (!Epi::AFTER_DRAIN) { E(acc, cur, wr, wc, fr, fq); S.done(cur); }
        PG8_STAMP();
        if (!has_next) break;
#pragma unroll
        for (int a = 0; a < 2; ++a)
#pragma unroll
            for (int b = 0; b < 2; ++b)
#pragma unroll
                for (int m = 0; m < 4; ++m)
#pragma unroll
                    for (int n = 0; n < 2; ++n) acc[a][b][m][n] = (f32x4){0.f, 0.f, 0.f, 0.f};
        cur = nxt; cA = nA; cB = nB; ++ui;
    }
    PG8_WAIT_V(0);
    if (wr == 0) PG8_BAR;
    PG8_BAR;
    if constexpr (Epi::AFTER_DRAIN) { E.fused(acc, cur, wr, wc, fr, fq, lds, wid, lane); S.done(cur); }
    PG8_STAMP();
    if (STAMP && wid == 0) { stamps[lane] = lane < nts ? (((unsigned long long)(unsigned)ts_hi << 32) | (unsigned)ts_lo) : 0ull;
        if (lane == 62) stamps[62] = rt_entry; if (lane == 63) stamps[63] = (unsigned long long)wall_clock64(); }
#undef PG8_STAMP
#undef PG8_SA
#undef PG8_SB
#undef PG8_STAGE
#undef PG8_LDA
#undef PG8_LDB
#undef PG8_MMA
#undef PG8_WAIT_V
#undef PG8_WAIT_L
#undef PG8_BAR
#undef PG8_SCHED
}
}

using pg8::bf16_t; using pg8::bf16x8; using pg8::f32x4; using pg8::u32x4; using pg8::cvt_pk_bf16;
typedef unsigned u32x2 __attribute__((ext_vector_type(2)));

constexpr int MP = 16384, MS = 512, MT = MP + MS, DM = 1024, ZS = 3328, NPAD = 3584, NIN = 3336;
constexpr float EPSF = 1e-6f;
constexpr int C_AQ = 0, C_AK = 512, C_AV = 640, C_AG = 768, C_DQKV = 1280, C_DG = 2816;
constexpr size_t O_YP = 0, O_YS = 16777216, O_PWK = 17301504, O_PWV = 17432576, O_PCONV = 17563648, O_PDELTA = 17600512,
                 O_SWK = 18124800, O_SWV = 26513408, O_SCONV = 34902016, O_SDELTA = 37261312;
constexpr size_t W_WINT = 0, W_WOUTT = W_WINT + (size_t)4 * NPAD * DM * 2, W_XB = W_WOUTT + (size_t)4 * DM * DM * 2,
                 W_Z = W_XB + (size_t)MT * DM * 2, W_Z8 = W_Z + (size_t)MT * ZS * 2, W_SS = W_Z8 + (size_t)MT * 8 * 4,
                 W_MIX = W_SS + (size_t)4 * MT * 16 * 4, W_PU = W_MIX + (size_t)MT * DM * 2, W_PW = W_PU + (size_t)1024 * 32768,
                 W_PQG = W_PW + (size_t)1024 * 16384, W_PKD = W_PQG + (size_t)1024 * 16384, W_PAQK = W_PKD + (size_t)1024 * 16384,
                 W_PGL = W_PAQK + (size_t)1024 * 8192, W_PG = W_PGL + 4096, W_PSS = W_PG + (size_t)1024 * 16384, W_ROPE = W_PSS + (size_t)MP * 16 * 4, W_SST = W_ROPE + (size_t)8196 * 16 * 4, W_PART = W_SST + (size_t)8 * 16384 * 4, W_BAR = W_PART + (size_t)4 * MS * DM * 4, W_CTR = W_BAR + (size_t)XCD_BAR_WORDS * 4, W_END = W_CTR + 64;
constexpr int LDS_USER = 162816, LDS_BYTES = LDS_USER + 16;

struct Params {
    const float *x_prompt, *x_sample, *cache_k, *cache_v, *state_conv, *state_delta, *norm_g, *w_in, *q_norm_g, *k_norm_g, *sinks, *conv_w, *a_log,
        *dt_bias, *dn_norm_g, *w_out;
    float* out; unsigned char* ws;
    int phase_lo, phase_hi, coop, pad;
};

DI float bf2f(bf16_t b) { return __uint_as_float(((unsigned)b) << 16); }
DI bf16_t f2bf(float f) { unsigned u = __float_as_uint(f); u += 0x7fffu + ((u >> 16) & 1u); return (bf16_t)(u >> 16); }
DI unsigned pk2(float lo, float hi) { return (unsigned)f2bf(lo) | ((unsigned)f2bf(hi) << 16); }
DI float lo16(unsigned w) { return __uint_as_float(w << 16); }
DI float hi16(unsigned w) { return __uint_as_float(w & 0xffff0000u); }
DI float wave_sum(float v) {
#pragma unroll
    for (int o = 1; o < 64; o <<= 1) v += __shfl_xor(v, o);
    return v;
}
DI float wave_max(float v) {
#pragma unroll
    for (int o = 1; o < 64; o <<= 1) v = fmaxf(v, __shfl_xor(v, o));
    return v;
}
DI float siluf(float x) { return x * __builtin_amdgcn_rcpf(1.0f + __expf(-x)); }
DI float sigmoidf_(float x) { return __builtin_amdgcn_rcpf(1.0f + __expf(-x)); }
DI float softplusf_(float x) { return x > 20.f ? x : log1pf(expf(x)); }
DI float rope_inv(int i) { return exp2f(-(float)i * (18.931568569324174f / 8.0f)); }
DI void sincos_rev(float ang, float& sn, float& cs) {
    double a = (double)ang * 0.15915494309189535; a -= rint(a);
    const float r = (float)a; sn = __builtin_amdgcn_sinf(r); cs = __builtin_amdgcn_cosf(r);
}
DI int opaque_zero() { int z; asm volatile("v_mov_b32 %0, 0" : "=v"(z)); return z; }
template <int CTRL> DI float dpp_mov(float x) { return __builtin_bit_cast(float, __builtin_amdgcn_update_dpp(0, __builtin_bit_cast(int, x), CTRL, 0xf, 0xf, true)); }
DI float row16_sum(float q) {
    q += dpp_mov<0xB1>(q); q += dpp_mov<0x4E>(q); q += dpp_mov<0x128>(q); q += dpp_mov<0x124>(q); return q;
}
DI float row16_transpose_reduce(const float (&x)[16], int fr) {
    float y8[8], y4[4], y2[2];
    const bool h8 = fr & 8, h4 = fr & 4, h2 = fr & 2, h1 = fr & 1;
#pragma unroll
    for (int i = 0; i < 8; ++i) { const float keep = h8 ? x[8 + i] : x[i], send = h8 ? x[i] : x[8 + i]; y8[i] = keep + dpp_mov<0x140>(send); }
#pragma unroll
    for (int i = 0; i < 4; ++i) { const float keep = h4 ? y8[4 + i] : y8[i], send = h4 ? y8[i] : y8[4 + i]; y4[i] = keep + dpp_mov<0x141>(send); }
#pragma unroll
    for (int i = 0; i < 2; ++i) { const float keep = h2 ? y4[2 + i] : y4[i], send = h2 ? y4[i] : y4[2 + i]; y2[i] = keep + dpp_mov<0x4E>(send); }
    const float keep = h1 ? y2[1] : y2[0], send = h1 ? y2[0] : y2[1];
    return keep + dpp_mov<0xB1>(send);
}
DI int perm_pos(int c32) { return ((c32 >> 2) & 3) * 8 + (c32 >> 4) * 4 + (c32 & 3); }

DI void transpose_item4(const float* W, int Nsrc, int nvalid, const float* g, bf16_t* WT, int kb, int nb4, float* tile, int tid) {
    const int k0 = kb * 64, n0 = nb4 * 256;
    {
        const int nn = tid & 63, kk0 = tid >> 6;
        float v[4][8];
#pragma unroll
        for (int q = 0; q < 4; ++q)
#pragma unroll
            for (int i = 0; i < 8; ++i) {
                const int n = n0 + 64 * q + nn;
                v[q][i] = W[(size_t)(k0 + kk0 + 8 * i) * Nsrc + (n < nvalid ? n : 0)];
                if (n >= nvalid) v[q][i] = 0.f;
            }
#pragma unroll
        for (int i = 0; i < 8; ++i) {
            const float gs = g ? g[k0 + kk0 + 8 * i] : 1.0f;
#pragma unroll
            for (int q = 0; q < 4; ++q) tile[q * (64 * 65) + (kk0 + 8 * i) * 65 + nn] = v[q][i] * gs;
        }
    }
    __syncthreads();
    {
        const int n = tid >> 3, c = tid & 7;
#pragma unroll
        for (int q = 0; q < 4; ++q) {
            const float* s = tile + q * (64 * 65) + (8 * c) * 65 + n;
            u32x4 o; o.x = cvt_pk_bf16(s[0], s[65]); o.y = cvt_pk_bf16(s[2 * 65], s[3 * 65]); o.z = cvt_pk_bf16(s[4 * 65], s[5 * 65]); o.w = cvt_pk_bf16(s[6 * 65], s[7 * 65]);
            *(u32x4*)(WT + (size_t)(n0 + 64 * q + n) * DM + k0 + 8 * c) = o;
        }
    }
    __syncthreads();
}

DI void weights_layer(const Params& p, int l, int w0, int nw, unsigned char* smem, const int tid) {
    float* tile = (float*)smem;
    for (int it = w0; it < 224 + 64; it += nw) {
        if (it < 224) { const int kb = it / 14, nb4 = it % 14;
            transpose_item4(p.w_in + (size_t)l * DM * NIN, NIN, NIN, p.norm_g + l * DM, (bf16_t*)(p.ws + W_WINT) + (size_t)l * NPAD * DM, kb, nb4, tile, tid); }
        else { const int r = it - 224, kb = r / 4, nb4 = r % 4;
            transpose_item4(p.w_out + (size_t)l * DM * DM, DM, DM, nullptr, (bf16_t*)(p.ws + W_WOUTT) + (size_t)l * DM * DM, kb, nb4, tile, tid); }
    }
}
DI void phase0(const Params& p, unsigned char* smem, const int tid) {
    const int wid = tid >> 6, lane = tid & 63;
    float* tile = (float*)smem;
    constexpr int I_IN = 1 * 16 * 14, I_OUT = 1 * 16 * 4, I_X = MT / 16;
    for (int t = blockIdx.x * 512 + tid; t < 8196 * 8; t += gridDim.x * 512) {
        const int pos = t >> 3, i = t & 7;
        float sn, cs; sincos_rev((float)pos * rope_inv(i), sn, cs);
        float* r = (float*)(p.ws + W_ROPE) + (size_t)t * 2; r[0] = cs; r[1] = sn;
    }
    for (int it = blockIdx.x; it < I_IN + I_OUT + I_X; it += gridDim.x) {
        if (it < I_IN) {
            const int l = it / (16 * 14), r = it % (16 * 14), kb = r / 14, nb4 = r % 14;
            transpose_item4(p.w_in + (size_t)l * DM * NIN, NIN, NIN, p.norm_g + l * DM, (bf16_t*)(p.ws + W_WINT) + (size_t)l * NPAD * DM, kb, nb4, tile, tid);
        } else if (it < I_IN + I_OUT) {
            const int r0 = it - I_IN, l = r0 / 64, r = r0 % 64, kb = r / 4, nb4 = r % 4;
            transpose_item4(p.w_out + (size_t)l * DM * DM, DM, DM, nullptr, (bf16_t*)(p.ws + W_WOUTT) + (size_t)l * DM * DM, kb, nb4, tile, tid);
        } else {
            const int row0 = (it - I_IN - I_OUT) * 16 + wid * 2;
            f32x4 v[2][4];
#pragma unroll
            for (int rr = 0; rr < 2; ++rr) {
                const int row = row0 + rr;
                const float* src = row < MP ? p.x_prompt + (size_t)row * DM : p.x_sample + (size_t)(row - MP) * DM;
#pragma unroll
                for (int j = 0; j < 4; ++j) v[rr][j] = *(const f32x4*)(src + (lane + 64 * j) * 4);
            }
#pragma unroll
            for (int rr = 0; rr < 2; ++rr) {
                const int row = row0 + rr;
                bf16_t* dst = (bf16_t*)(p.ws + W_XB) + (size_t)row * DM;
                float s = 0.f;
#pragma unroll
                for (int j = 0; j < 4; ++j) {
                    const f32x4 x = v[rr][j];
                    s += x[0] * x[0] + x[1] * x[1] + x[2] * x[2] + x[3] * x[3];
                    u32x2 o; o.x = cvt_pk_bf16(x[0], x[1]); o.y = cvt_pk_bf16(x[2], x[3]);
                    *(u32x2*)(dst + (lane + 64 * j) * 4) = o;
                }
                s = wave_sum(s);
                float* ss = (float*)(p.ws + W_SS);
                if (lane < 16) ss[(size_t)row * 16 + lane] = lane == 0 ? s : 0.f;
            }
        }
    }
}

struct EpiIn {
    static constexpr bool PERM = true, AFTER_DRAIN = false;
    bf16_t* Z; float* z8; const float* ss;
    DI void operator()(const f32x4 (&acc)[2][2][4][2], const pg8::Unit& u, int wr, int wc, int fr, int fq) const {
        const int row0 = u.pm * 256 + wr * 64 + fr;
#pragma unroll
        for (int ai = 0; ai < 2; ++ai)
#pragma unroll
            for (int m = 0; m < 4; ++m) {
                const int row = row0 + ai * 128 + m * 16;
                const f32x4* sp = (const f32x4*)(ss + (size_t)row * 16);
                const f32x4 s0 = sp[0], s1 = sp[1], s2 = sp[2], s3 = sp[3];
                const float ssum = (((s0[0] + s0[1]) + (s0[2] + s0[3])) + ((s1[0] + s1[1]) + (s1[2] + s1[3]))) + (((s2[0] + s2[1]) + (s2[2] + s2[3])) + ((s3[0] + s3[1]) + (s3[2] + s3[3])));
                const float rstd = rsqrtf(ssum * (1.0f / DM) + EPSF);
                if (u.pn < 13) {
                    bf16_t* rowp = Z + (size_t)row * ZS + u.pn * 256 + wc * 32 + 8 * fq;
#pragma unroll
                    for (int bj = 0; bj < 2; ++bj) {
                        const f32x4 v0 = acc[ai][bj][m][0] * rstd, v1 = acc[ai][bj][m][1] * rstd;
                        u32x4 w; w.x = cvt_pk_bf16(v0[0], v0[1]); w.y = cvt_pk_bf16(v0[2], v0[3]); w.z = cvt_pk_bf16(v1[0], v1[1]); w.w = cvt_pk_bf16(v1[2], v1[3]);
                        *(u32x4*)(rowp + bj * 128) = w;
                    }
                } else if (wc == 0 && fq == 0) {
                    *(f32x4*)(z8 + (size_t)row * 8) = acc[ai][0][m][0] * rstd;
                    *(f32x4*)(z8 + (size_t)row * 8 + 4) = acc[ai][0][m][1] * rstd;
                }
            }
    }
};
struct EpiOut {
    static constexpr bool PERM = false, AFTER_DRAIN = false;
    const float* xin_p; const float* xin_s; float* xout; bf16_t* xb; float* ssn; float* part;
    DI void operator()(const f32x4 (&acc)[2][2][4][2], const pg8::Unit& u, int wr, int wc, int fr, int fq) const {
        const int row0 = u.pm * 256 + wr * 64 + fr, col0 = u.pn * 256 + wc * 32 + 4 * fq;
        if (part) {
#pragma unroll
            for (int ai = 0; ai < 2; ++ai)
#pragma unroll
                for (int m = 0; m < 4; ++m) {
                    float* dst = part + (size_t)(row0 + ai * 128 + m * 16 - MP) * DM + col0;
#pragma unroll
                    for (int bj = 0; bj < 2; ++bj)
#pragma unroll
                        for (int n = 0; n < 2; ++n) *(f32x4*)(dst + bj * 128 + n * 16) = acc[ai][bj][m][n];
                }
            return;
        }
#pragma unroll
        for (int ai = 0; ai < 2; ++ai)
#pragma unroll
            for (int m = 0; m < 4; ++m) {
                const int row = row0 + ai * 128 + m * 16;
                const float* src = (row < MP ? xin_p + (size_t)row * DM : xin_s + (size_t)(row - MP) * DM) + col0;
                float* dst = xout + (size_t)row * DM + col0;
                bf16_t* dstb = xb + (size_t)row * DM + col0;
                float sq = 0.f;
#pragma unroll
                for (int bj = 0; bj < 2; ++bj)
#pragma unroll
                    for (int n = 0; n < 2; ++n) {
                        const f32x4 v = __builtin_nontemporal_load((const f32x4*)(src + bj * 128 + n * 16)) + acc[ai][bj][m][n];
                        __builtin_nontemporal_store(v, (f32x4*)(dst + bj * 128 + n * 16));
                        if (ssn) {
                            u32x2 o; o.x = cvt_pk_bf16(v[0], v[1]); o.y = cvt_pk_bf16(v[2], v[3]);
                            *(u32x2*)(dstb + bj * 128 + n * 16) = o;
                            sq += v[0] * v[0] + v[1] * v[1] + v[2] * v[2] + v[3] * v[3];
                        }
                    }
                if (ssn) {
                    sq += __shfl_xor(sq, 16); sq += __shfl_xor(sq, 32);
                    if (fq == 0) ssn[(size_t)row * 16 + u.pn * 4 + wc] = sq;
                }
                asm volatile("" ::: "memory");
            }
    }
};

struct OutOrder {
    pg8::StaticOrder so; int fixed; pg8::Unit fu;
    DI bool next(int i, pg8::Unit& u) const { if (fixed) { if (i) return false; u = fu; return true; } return so.next(i, u); }
    DI void a_ready(const pg8::Unit&) const {}
    DI void done(const pg8::Unit&) const {}
};
constexpr int PL_G = 0, PL_BETA = 256, PL_EG = 512, PL_K = 1024, PL_Q = PL_K + 64 * 272, PL_RHS = PL_Q + 64 * 272, PL_A = PL_RHS + 64 * 256 * 4,
              PL_AQK = PL_A + 64 * 68 * 4, PL_KDT = PL_AQK + 64 * 72 * 2, PL_T = PL_KDT + 128 * 72 * 2, PL_END = PL_T + 4 * 16 * 16 * 4;
static_assert(PL_END <= LDS_BYTES, "prep LDS");

DI u32x4 perm_chunk_bf16(const bf16_t* row, int s, int g) {
    const u32x2 a = *(const u32x2*)(row + 32 * s + 4 * g), b = *(const u32x2*)(row + 32 * s + 16 + 4 * g);
    u32x4 o; o.x = a.x; o.y = a.y; o.z = b.x; o.w = b.y; return o;
}

struct PrepPre { unsigned xw[3][11]; float db, da; u32x4 dgv[2]; };
DI void prep_preload(const Params& p, int item, const int tid, PrepPre& pre) {
    const int wid = tid >> 6, lane = tid & 63, c = 2 * lane;
    const int h = item & 3, n = (item >> 2) & 127, b = item >> 9, R0 = b * 8192 + n * 64;
    const bf16_t* Z = (const bf16_t*)(p.ws + W_Z);
    const float* z8 = (const float*)(p.ws + W_Z8);
#pragma unroll
    for (int part = 0; part < 3; ++part) {
        const int ch = part * 512 + h * 128 + c;
#pragma unroll
        for (int i = 0; i < 11; ++i) {
            const int r = 8 * wid - 3 + i;
            const bool ok = (n * 64 + r >= 0);
            const unsigned w = *(const unsigned*)(Z + (size_t)(R0 + (ok ? r : 0)) * ZS + C_DQKV + ch);
            pre.xw[part][i] = ok ? w : 0u;
        }
    }
    pre.db = z8[(size_t)(R0 + lane) * 8 + h]; pre.da = z8[(size_t)(R0 + lane) * 8 + 4 + h];
#pragma unroll
    for (int i = 0; i < 2; ++i) { const int q = tid + 512 * i; pre.dgv[i] = *(const u32x4*)(Z + (size_t)(R0 + (q >> 4)) * ZS + C_DG + h * 128 + (q & 15) * 8); }
}
#ifndef PROBE_STAGE
#define PROBE_STAGE (-1)
#endif
#define PSTAGE(s_) do { if (PROBE_STAGE >= 0) { const unsigned long long t1_ = __builtin_amdgcn_s_memrealtime(); if (PROBE_STAGE == (s_)) { while (__builtin_amdgcn_s_memrealtime() - t1_ < t1_ - pst_) __builtin_amdgcn_s_sleep(4); } pst_ = __builtin_amdgcn_s_memrealtime(); } } while (0)
DI void prep_item(const Params& p, int l, int item, int next_item, PrepPre& pre, const float (&cw0)[3][4], const float (&cw1)[3][4], unsigned char* smem, const int tid) {
    const int wid = tid >> 6, lane = tid & 63;
    unsigned long long pst_ = (PROBE_STAGE >= 0) ? __builtin_amdgcn_s_memrealtime() : 0ull;
    const int h = item & 3, n = (item >> 2) & 127, b = item >> 9;
    const int R0 = b * 8192 + n * 64;
    float* sG = (float*)(smem + PL_G); float* sBeta = (float*)(smem + PL_BETA); float* sEG = (float*)(smem + PL_EG);
    bf16_t* sK = (bf16_t*)(smem + PL_K); bf16_t* sQ = (bf16_t*)(smem + PL_Q);
    float* sRhs = (float*)(smem + PL_RHS); float* sA = (float*)(smem + PL_A);
    bf16_t* sAqk = (bf16_t*)(smem + PL_AQK); bf16_t* sKdT = (bf16_t*)(smem + PL_KDT);
    const bf16_t* Z = (const bf16_t*)(p.ws + W_Z);
    const float* z8 = (const float*)(p.ws + W_Z8);
    const int c = 2 * lane;
    unsigned xw[3][11];
#pragma unroll
    for (int part = 0; part < 3; ++part)
#pragma unroll
        for (int i = 0; i < 11; ++i) xw[part][i] = pre.xw[part][i];
    const float pre_db = pre.db, pre_da = pre.da;
    const u32x4 dgl0 = pre.dgv[0], dgl1 = pre.dgv[1];
    if (wid == 0) {
        const float db = pre_db, da = pre_da;
        const float beta = sigmoidf_(db);
        const float spx = da + p.dt_bias[l * 4 + h], spy = __expf(spx);
        const float sp = spx > 15.f ? spx : (spy < 1e-3f ? spy * (1.0f - 0.5f * spy) : __logf(1.0f + spy));
        const float gg = -__expf(p.a_log[l * 4 + h]) * sp;
        float G = gg;
#pragma unroll
        for (int o = 1; o < 64; o <<= 1) { const float t = __shfl_up(G, o); if (lane >= o) G += t; }
        const float eG = __expf(G);
        sG[lane] = G; sBeta[lane] = beta; sEG[lane] = eG;
        if (lane == 63) ((float*)(p.ws + W_PGL))[item] = eG;
    }
    __syncthreads();
    PSTAGE(0);
    const int z0 = opaque_zero();
    const float G63 = sG[63 + z0];
    {
        bf16_t* Qg = (bf16_t*)(p.ws + W_PQG) + (size_t)item * 8192;
#pragma unroll
        for (int part = 0; part < 3; ++part) {
            float y0[8], y1[8], ssq[8];
#pragma unroll
            for (int tl = 0; tl < 8; ++tl) {
                float a0 = 0.f, a1 = 0.f;
#pragma unroll
                for (int j = 0; j < 4; ++j) { a0 += lo16(xw[part][tl + j]) * cw0[part][j]; a1 += hi16(xw[part][tl + j]) * cw1[part][j]; }
                y0[tl] = siluf(a0); y1[tl] = siluf(a1);
                ssq[tl] = y0[tl] * y0[tl] + y1[tl] * y1[tl];
            }
            if (part < 2) {
#pragma unroll
                for (int tl = 0; tl < 8; ++tl) ssq[tl] = row16_sum(ssq[tl]);
#pragma unroll
                for (int tl = 0; tl < 8; ++tl) ssq[tl] += __shfl_xor(ssq[tl], 16);
#pragma unroll
                for (int tl = 0; tl < 8; ++tl) ssq[tl] += __shfl_xor(ssq[tl], 32);
            }
#pragma unroll
            for (int tl = 0; tl < 8; ++tl) {
                const int t = 8 * wid + tl;
                if (part == 2) {
                    const float bt = sBeta[t + z0];
                    sRhs[t * 256 + c] = y0[tl] * bt; sRhs[t * 256 + c + 1] = y1[tl] * bt;
                } else {
                    float sc = rsqrtf(ssq[tl] + EPSF);
                    if (part == 0) {
                        sc *= 0.08838834764831845f;
                        const float q0 = y0[tl] * sc, q1 = y1[tl] * sc;
                        *(unsigned*)(sQ + t * 136 + c) = cvt_pk_bf16(q0, q1);
                        const float eg = sEG[t + z0];
                        *(unsigned*)(Qg + t * 128 + (c & ~31) + perm_pos(c & 31)) = cvt_pk_bf16(q0 * eg, q1 * eg);
                    } else {
                        const float k0 = y0[tl] * sc, k1 = y1[tl] * sc;
                        *(unsigned*)(sK + t * 136 + c) = cvt_pk_bf16(k0, k1);
                        const float be = sBeta[t + z0] * sEG[t + z0];
                        sRhs[t * 256 + 128 + c] = k0 * be; sRhs[t * 256 + 128 + c + 1] = k1 * be;
                        const float kd = __expf(G63 - sG[t + z0]);
                        const unsigned kw = cvt_pk_bf16(k0 * kd, k1 * kd);
                        sKdT[c * 72 + t] = (bf16_t)(kw & 0xffffu); sKdT[(c + 1) * 72 + t] = (bf16_t)(kw >> 16);
                    }
                }
            }
        }
        if (n == 127 && tid < 384) {
            const int part = tid >> 7, cc = tid & 127, ch = part * 512 + h * 128 + cc;
#pragma unroll
            for (int r = 0; r < 3; ++r)
                p.out[O_PCONV + ((size_t)(l * 2 + b) * 3 + r) * 1536 + ch] = bf2f(Z[(size_t)(b * 8192 + 8189 + r) * ZS + C_DQKV + ch]);
        }
    }
    __syncthreads();
    PSTAGE(1);
    {
        const int fr = lane & 15, fq = lane >> 4;
#pragma unroll
        for (int qq = 0; qq < 3; ++qq) {
            const int q = wid + 8 * qq;
            if (q < 20) {
                const int mat = q >= 10, r = mat ? q - 10 : q;
                const int ti = r >= 6 ? 3 : (r >= 3 ? 2 : (r >= 1 ? 1 : 0)), tj = r - (ti * (ti + 1)) / 2;
                const bf16_t* Arows = mat ? sQ : sK;
                f32x4 acc = {0.f, 0.f, 0.f, 0.f};
#pragma unroll
                for (int ks = 0; ks < 4; ++ks) {
                    const bf16x8 afr = *(const bf16x8*)(Arows + (16 * ti + fr) * 136 + ks * 32 + fq * 8);
                    const bf16x8 bfr = *(const bf16x8*)(sK + (16 * tj + fr) * 136 + ks * 32 + fq * 8);
                    acc = __builtin_amdgcn_mfma_f32_16x16x32_bf16(afr, bfr, acc, 0, 0, 0);
                }
                const int j = 16 * tj + fr; const float Gj = sG[j];
#pragma unroll
                for (int e = 0; e < 4; ++e) {
                    const int i = 16 * ti + 4 * fq + e;
                    const float dec = __expf(sG[i] - Gj);
                    if (mat == 0) sA[i * 68 + j] = (i > j) ? -(acc[e] * sBeta[i] * dec) : 0.f;
                    else sAqk[i * 72 + j] = (i >= j) ? f2bf(acc[e] * dec) : (bf16_t)0;
                }
            }
        }
        for (int z = tid; z < 6 * 64; z += 512) {
            const int tz = z >> 6, w4 = z & 63, ti = tz < 3 ? 0 : (tz < 5 ? 1 : 2), tj = tz < 3 ? tz + 1 : (tz < 5 ? tz - 1 : 3);
            const int i = 16 * ti + (w4 >> 2), j0 = 16 * tj + (w4 & 3) * 4;
            *(u32x2*)(sAqk + i * 72 + j0) = (u32x2){0u, 0u};
        }
    }
    __syncthreads();
    PSTAGE(2);
    if (next_item >= 0) prep_preload(p, next_item, tid, pre);
    {
#pragma unroll
        for (int i = 0; i < 2; ++i) {
            const int q = tid + 512 * i, r = q >> 4, c8 = (q & 15) * 8;
            const u32x4 w = i ? dgl1 : dgl0;
            const f32x4 g0 = *(const f32x4*)(p.dn_norm_g + l * 128 + c8), g1 = *(const f32x4*)(p.dn_norm_g + l * 128 + c8 + 4);
            u32x4 o;
            o.x = cvt_pk_bf16(siluf(lo16(w.x)) * g0[0], siluf(hi16(w.x)) * g0[1]); o.y = cvt_pk_bf16(siluf(lo16(w.y)) * g0[2], siluf(hi16(w.y)) * g0[3]);
            o.z = cvt_pk_bf16(siluf(lo16(w.z)) * g1[0], siluf(hi16(w.z)) * g1[1]); o.w = cvt_pk_bf16(siluf(lo16(w.w)) * g1[2], siluf(hi16(w.w)) * g1[3]);
            *(u32x4*)(sK + r * 136 + c8) = o;
        }
    }
    {
        const int fr = lane & 15, fq = lane >> 4, t2 = tid - 256;
        bf16_t* Aq = (bf16_t*)(p.ws + W_PAQK) + (size_t)item * 4096;
        bf16_t* Kd = (bf16_t*)(p.ws + W_PKD) + (size_t)item * 8192;
        float* sT = (float*)(smem + PL_T);
        if (tid < 64) {
            const int I = tid >> 4, cidx = tid & 15;
            const float* Ab = sA + (16 * I) * 68 + 16 * I;
            float tcol[16];
#pragma unroll
            for (int i = 0; i < 16; ++i) {
                float a0 = (i == cidx) ? 1.0f : 0.0f, a1 = 0.f;
#pragma unroll
                for (int j4 = 0; j4 < (i + 3) / 4; ++j4) {
                    const f32x4 av = *(const f32x4*)(Ab + i * 68 + 4 * j4);
#pragma unroll
                    for (int e = 0; e < 4; ++e) if (4 * j4 + e < i) { if (e & 1) a1 += av[e] * tcol[4 * j4 + e]; else a0 += av[e] * tcol[4 * j4 + e]; }
                }
                tcol[i] = a0 + a1;
                sT[(I * 16 + i) * 16 + cidx] = tcol[i];
            }
        } else if (tid >= 256) {
#pragma unroll
            for (int i2 = 0; i2 < 2; ++i2) { const int q = t2 + 256 * i2, r = q >> 3, c8 = q & 7, s = c8 >> 2, g = c8 & 3; *(u32x4*)(Aq + r * 64 + 32 * s + 8 * g) = perm_chunk_bf16(sAqk + r * 72, s, g); }
#pragma unroll
            for (int i2 = 0; i2 < 4; ++i2) { const int q = t2 + 256 * i2, r = q >> 3, c8 = q & 7, s = c8 >> 2, g = c8 & 3; *(u32x4*)(Kd + r * 64 + 32 * s + 8 * g) = perm_chunk_bf16(sKdT + r * 72, s, g); }
        }
        __syncthreads();
        {
            f32x4 dacc[2];
#pragma unroll
            for (int uu = 0; uu < 2; ++uu) {
                const int CT = wid + 8 * uu;
                dacc[uu] = (f32x4){0.f, 0.f, 0.f, 0.f};
#pragma unroll
                for (int ks = 0; ks < 4; ++ks) {
                    const float av = sT[fr * 16 + 4 * ks + fq];
                    const float bv = sRhs[(4 * ks + fq) * 256 + 16 * CT + fr];
                    dacc[uu] = __builtin_amdgcn_mfma_f32_16x16x4f32(av, bv, dacc[uu], 0, 0, 0);
                }
            }
#pragma unroll
            for (int uu = 0; uu < 2; ++uu) {
                float* ct = sRhs + (4 * fq) * 256 + 16 * (wid + 8 * uu) + fr;
                ct[0] = dacc[uu][0]; ct[256] = dacc[uu][1]; ct[512] = dacc[uu][2]; ct[768] = dacc[uu][3];
            }
        }
        __syncthreads();
#pragma unroll
        for (int I = 0; I < 3; ++I) {
#pragma unroll
            for (int uu = 0; uu < (3 - I) * 2; ++uu) {
                const int u = wid + 8 * uu;
                const int RT = I + 1 + (u >> 4), CT = u & 15;
                float* ct = sRhs + (16 * RT + 4 * fq) * 256 + 16 * CT + fr;
                f32x4 cacc = {ct[0], ct[256], ct[512], ct[768]};
#pragma unroll
                for (int ks = 0; ks < 4; ++ks) {
                    const float av = sA[(16 * RT + fr) * 68 + 16 * I + 4 * ks + fq];
                    const float bv = sRhs[(16 * I + 4 * ks + fq) * 256 + 16 * CT + fr];
                    cacc = __builtin_amdgcn_mfma_f32_16x16x4f32(av, bv, cacc, 0, 0, 0);
                }
                if (uu < 2) {
                    f32x4 xacc = {0.f, 0.f, 0.f, 0.f};
#pragma unroll
                    for (int e = 0; e < 4; ++e) xacc = __builtin_amdgcn_mfma_f32_16x16x4f32(sT[((I + 1) * 16 + fr) * 16 + 4 * fq + e], cacc[e], xacc, 0, 0, 0);
                    cacc = xacc;
                }
                ct[0] = cacc[0]; ct[256] = cacc[1]; ct[512] = cacc[2]; ct[768] = cacc[3];
            }
            __syncthreads();
        }
    }
    PSTAGE(3);
    {
        float* U = (float*)(p.ws + W_PU) + (size_t)item * 8192;
        bf16_t* Gt4 = (bf16_t*)(p.ws + W_PG) + (size_t)item * 8192;
#pragma unroll
        for (int i = 0; i < 4; ++i) {
            const int q = tid + 512 * i, cc = q & 127, tf = q >> 7, t = tf >> 2, fq = tf & 3;
            const int di = (((cc >> 4) * 64 + fq * 16 + (cc & 15)) * 16 + t * 4);
            f32x4 uv;
#pragma unroll
            for (int e = 0; e < 4; ++e) uv[e] = sRhs[(16 * t + 4 * fq + e) * 256 + cc];
            *(f32x4*)(U + di) = uv;
            const bf16_t* gt = sK + (16 * t + 4 * fq) * 136 + cc;
            u32x2 gw; gw.x = (unsigned)gt[0] | ((unsigned)gt[136] << 16); gw.y = (unsigned)gt[272] | ((unsigned)gt[408] << 16);
            *(u32x2*)(Gt4 + di) = gw;
        }
        bf16_t* Wn = (bf16_t*)(p.ws + W_PW) + (size_t)item * 8192;
#pragma unroll
        for (int i = 0; i < 2; ++i) {
            const int q = tid + 512 * i, r = q >> 4, c16 = q & 15, s = c16 >> 2, g = c16 & 3;
            const f32x4 a = *(const f32x4*)(sRhs + r * 256 + 128 + 32 * s + 4 * g), bb = *(const f32x4*)(sRhs + r * 256 + 128 + 32 * s + 16 + 4 * g);
            u32x4 o; o.x = cvt_pk_bf16(-a[0], -a[1]); o.y = cvt_pk_bf16(-a[2], -a[3]); o.z = cvt_pk_bf16(-bb[0], -bb[1]); o.w = cvt_pk_bf16(-bb[2], -bb[3]);
            *(u32x4*)(Wn + r * 128 + 32 * s + 8 * g) = o;
        }
    }
    __syncthreads();
    PSTAGE(4);
}

DI void sdelta_item(const Params& p, int l, int item, unsigned char* smem, const int tid) {
    const int wid = tid >> 6, lane = tid & 63;
    const int h = item & 3, b = item >> 2;
    float* sY = (float*)smem;
    float* sRed = sY + 3 * 4 * 128;
    float* sBG = sRed + 4 * 2 * 4 * 128;
    const bf16_t* Z = (const bf16_t*)(p.ws + W_Z);
    const float* z8 = (const float*)(p.ws + W_Z8);
    const int RS = MP + b * 4;
    const int v = tid & 127, kq = tid >> 7;
    float S[32];
    const float* S0 = p.state_delta + ((size_t)(l * 128 + b) * 4 + h) * 16384;
#pragma unroll
    for (int i = 0; i < 32; ++i) S[i] = __builtin_nontemporal_load(S0 + (size_t)(kq * 32 + i) * 128 + v);
    if (tid < 384) {
        const int part = tid >> 7, c = tid & 127, ch = part * 512 + h * 128 + c;
        float xx[7];
#pragma unroll
        for (int r = 0; r < 3; ++r) xx[r] = p.state_conv[((size_t)(l * 128 + b) * 3 + r) * 1536 + ch];
#pragma unroll
        for (int t = 0; t < 4; ++t) xx[3 + t] = bf2f(Z[(size_t)(RS + t) * ZS + C_DQKV + ch]);
#pragma unroll
        for (int r = 0; r < 3; ++r) p.out[O_SCONV + ((size_t)(l * 128 + b) * 3 + r) * 1536 + ch] = xx[4 + r];
        float cw[4];
#pragma unroll
        for (int j = 0; j < 4; ++j) cw[j] = p.conv_w[(size_t)(l * 4 + j) * 1536 + ch];
#pragma unroll
        for (int t = 0; t < 4; ++t) {
            float y = 0.f;
#pragma unroll
            for (int j = 0; j < 4; ++j) y += xx[t + j] * cw[j];
            sY[(part * 4 + t) * 128 + c] = siluf(y);
        }
    } else if (tid < 388) {
        const int t = tid - 384;
        const float db = z8[(size_t)(RS + t) * 8 + h], da = z8[(size_t)(RS + t) * 8 + 4 + h];
        sBG[t] = sigmoidf_(db);
        sBG[4 + t] = expf(-expf(p.a_log[l * 4 + h]) * softplusf_(da + p.dt_bias[l * 4 + h]));
    }
    __syncthreads();
    {
        float* row = sY + wid * 128;
        const float a0 = row[lane], a1 = row[lane + 64];
        float sc = rsqrtf(wave_sum(a0 * a0 + a1 * a1) + EPSF);
        if (wid < 4) sc *= 0.08838834764831845f;
        row[lane] = a0 * sc; row[lane + 64] = a1 * sc;
    }
    __syncthreads();
#pragma unroll 1
    for (int t = 0; t < 4; ++t) {
        const float a = sBG[4 + t], beta = sBG[t];
        const float* qv = sY + (0 * 4 + t) * 128 + kq * 32; const float* kv = sY + (1 * 4 + t) * 128 + kq * 32;
        float part = 0.f;
#pragma unroll
        for (int i = 0; i < 32; ++i) { S[i] *= a; part += kv[i] * S[i]; }
        float* red = sRed + (t * 2 + 0) * 512;
        red[kq * 128 + v] = part;
        __syncthreads();
        const float kS = red[v] + red[128 + v] + red[256 + v] + red[384 + v];
        const float vnew = (sY[(2 * 4 + t) * 128 + v] - kS) * beta;
        float po = 0.f;
#pragma unroll
        for (int i = 0; i < 32; ++i) { S[i] += kv[i] * vnew; po += qv[i] * S[i]; }
        float* red2 = sRed + (t * 2 + 1) * 512;
        red2[kq * 128 + v] = po;
    }
    __syncthreads();
    float* Sout = p.out + O_SDELTA + ((size_t)(l * 128 + b) * 4 + h) * 16384;
#pragma unroll
    for (int i = 0; i < 32; ++i) __builtin_nontemporal_store(S[i], Sout + (size_t)(kq * 32 + i) * 128 + v);
    if (wid < 4) {
        const int t = wid;
        const float* red2 = sRed + (t * 2 + 1) * 512;
        float o0 = red2[lane] + red2[128 + lane] + red2[256 + lane] + red2[384 + lane];
        float o1 = red2[lane + 64] + red2[128 + lane + 64] + red2[256 + lane + 64] + red2[384 + lane + 64];
        const float rstd = rsqrtf(wave_sum(o0 * o0 + o1 * o1) * (1.0f / 128.f) + EPSF);
        const bf16_t* dg = Z + (size_t)(RS + t) * ZS + C_DG + h * 128;
        bf16_t* mix = (bf16_t*)(p.ws + W_MIX) + (size_t)(RS + t) * DM + 512 + h * 128;
        mix[lane] = f2bf(o0 * rstd * p.dn_norm_g[l * 128 + lane] * siluf(bf2f(dg[lane])));
        mix[lane + 64] = f2bf(o1 * rstd * p.dn_norm_g[l * 128 + lane + 64] * siluf(bf2f(dg[lane + 64])));
    }
    __syncthreads();
}

DI void sattn_item(const Params& p, int l, int item, unsigned char* smem, const int tid) {
    const int wid = tid >> 6, lane = tid & 63;
    const int kvh = item & 1, b = item >> 1;
    float* sK = (float*)smem;
    float* sV = sK + 132 * 65;
    float* sQ = sV + 132 * 64;
    float* sP = sQ + 16 * 64;
    const bf16_t* Z = (const bf16_t*)(p.ws + W_Z);
    const int RS = MP + b * 4;
    const float* ck = p.cache_k + (size_t)(l * 128 + b) * 128 * 128 + kvh * 64;
    const float* cv = p.cache_v + (size_t)(l * 128 + b) * 128 * 128 + kvh * 64;
    float* ok = p.out + O_SWK + (size_t)(l * 128 + b) * 128 * 128 + kvh * 64;
    float* ov = p.out + O_SWV + (size_t)(l * 128 + b) * 128 * 128 + kvh * 64;
    for (int q = tid; q < 128 * 16; q += 512) {
        const int i = q >> 4, d4 = (q & 15) * 4;
        const f32x4 kk = __builtin_nontemporal_load((const f32x4*)(ck + (size_t)i * 128 + d4)), vv = __builtin_nontemporal_load((const f32x4*)(cv + (size_t)i * 128 + d4));
        sK[i * 65 + d4] = kk[0]; sK[i * 65 + d4 + 1] = kk[1]; sK[i * 65 + d4 + 2] = kk[2]; sK[i * 65 + d4 + 3] = kk[3];
        *(f32x4*)(sV + i * 64 + d4) = vv;
        if (i >= 4) { __builtin_nontemporal_store(kk, (f32x4*)(ok + (size_t)(i - 4) * 128 + d4)); __builtin_nontemporal_store(vv, (f32x4*)(ov + (size_t)(i - 4) * 128 + d4)); }
    }
    for (int r = wid; r < 24; r += 8) {
        if (r >= 4 && r < 8) {
            const int t = r - 4;
            const float x = bf2f(Z[(size_t)(RS + t) * ZS + C_AV + kvh * 64 + lane]);
            sV[(128 + t) * 64 + lane] = x; ov[(size_t)(124 + t) * 128 + lane] = x;
        } else {
            const bool isk = r < 4; const int t = isk ? r : (r - 8) >> 2, hh = isk ? 0 : (r - 8) & 3;
            const float x = bf2f(Z[(size_t)(RS + t) * ZS + (isk ? C_AK + kvh * 64 : C_AQ + (kvh * 4 + hh) * 64) + lane]);
            const float rstd = rsqrtf(wave_sum(x * x) * (1.0f / 64.f) + EPSF);
            float y = x * rstd * (isk ? p.k_norm_g[l * 64 + lane] : p.q_norm_g[l * 64 + lane]);
            const float yp = __shfl_xor(y, 8);
            if (lane < 16) {
                const float ang = (float)(8192 + t) * rope_inv(lane & 7);
                float cs, sn; sincos_rev(ang, sn, cs);
                y = lane < 8 ? y * cs - yp * sn : y * cs + yp * sn;
            }
            if (isk) { sK[(128 + t) * 65 + lane] = y; ok[(size_t)(124 + t) * 128 + lane] = y; }
            else sQ[(t * 4 + hh) * 64 + lane] = y;
        }
    }
    __syncthreads();
    for (int q = tid; q < 16 * 132; q += 512) {
        const int r = q / 132, key = q % 132, t = r >> 2;
        float s = 0.f;
#pragma unroll 16
        for (int d = 0; d < 64; ++d) s += sQ[r * 64 + d] * sK[key * 65 + d];
        const bool valid = key < 128 ? (key >= t + 1) : (key - 128 <= t);
        sP[r * 136 + key] = valid ? s * 0.125f : -INFINITY;
    }
    __syncthreads();
    for (int r = wid; r < 16; r += 8) {
        const float sink = p.sinks[l * 8 + kvh * 4 + (r & 3)];
        const float s0 = sP[r * 136 + lane], s1 = sP[r * 136 + lane + 64], s2 = lane < 4 ? sP[r * 136 + lane + 128] : -INFINITY;
        const float m = fmaxf(wave_max(fmaxf(fmaxf(s0, s1), s2)), sink);
        const float p0 = __expf(s0 - m), p1 = __expf(s1 - m), p2 = lane < 4 ? __expf(s2 - m) : 0.f;
        const float den = wave_sum(p0 + p1 + p2) + __expf(sink - m);
        const float inv = 1.0f / den;
        sP[r * 136 + lane] = p0 * inv; sP[r * 136 + lane + 64] = p1 * inv; if (lane < 4) sP[r * 136 + lane + 128] = p2 * inv;
    }
    __syncthreads();
    for (int q = tid; q < 16 * 64; q += 512) {
        const int r = q >> 6, d = q & 63, t = r >> 2, hh = r & 3;
        float o = 0.f;
#pragma unroll 4
        for (int key = 0; key < 132; ++key) o += sP[r * 136 + key] * sV[key * 64 + d];
        const int colx = (kvh * 4 + hh) * 64 + d;
        const float ag = bf2f(Z[(size_t)(RS + t) * ZS + C_AG + colx]);
        ((bf16_t*)(p.ws + W_MIX))[(size_t)(RS + t) * DM + colx] = f2bf(o * siluf(ag));
    }
    __syncthreads();
}

constexpr int AL_Q = 0, AL_K = AL_Q + 4 * 64 * 144, AL_VT = AL_K + 192 * 144, AL_END = AL_VT + 64 * 400;
static_assert(AL_END <= LDS_BYTES, "attn LDS");
DI void pattn_item(const Params& p, int l, int item, unsigned char* smem, const int tid) {
    const int wid = tid >> 6, lane = tid & 63;
    const int kvh = item & 1, qb = (item >> 1) & 127, b = item >> 8;
    const int q0 = qb * 64;
    bf16_t* sQ = (bf16_t*)(smem + AL_Q); bf16_t* sK = (bf16_t*)(smem + AL_K); bf16_t* sVt = (bf16_t*)(smem + AL_VT);
    const bf16_t* Z = (const bf16_t*)(p.ws + W_Z);
    const bool last = (qb == 127);
    {
        const float* ROPE = (const float*)(p.ws + W_ROPE);
        const int sub = tid & 7;
        u32x4 raw[7];
#pragma unroll
        for (int i = 0; i < 7; ++i) {
            const int rid = (tid + 512 * i) >> 3;
            const bool isq = rid < 256;
            const int pos = isq ? q0 + (rid >> 2) : q0 - 128 + (rid - 256);
            const bf16_t* src = Z + (size_t)(b * 8192 + (pos >= 0 ? pos : 0)) * ZS + (isq ? C_AQ + (kvh * 4 + (rid & 3)) * 64 : C_AK + kvh * 64) + sub * 8;
            raw[i] = *(const u32x4*)src;
        }
#pragma unroll
        for (int i = 0; i < 7; ++i) {
            const int rid = (tid + 512 * i) >> 3;
            const bool isq = rid < 256;
            const int j = rid - 256;
            const int pos = isq ? q0 + (rid >> 2) : q0 - 128 + j;
            bf16_t* dst = (isq ? sQ + ((rid & 3) * 64 + (rid >> 2)) * 72 : sK + j * 72) + sub * 8;
            const u32x4 w = raw[i];
            float x[8] = {lo16(w.x), hi16(w.x), lo16(w.y), hi16(w.y), lo16(w.z), hi16(w.z), lo16(w.w), hi16(w.w)};
            float ss = 0.f;
#pragma unroll
            for (int e = 0; e < 8; ++e) ss += x[e] * x[e];
            ss += dpp_mov<0xB1>(ss); ss += dpp_mov<0x4E>(ss); ss += dpp_mov<0x141>(ss);
            const float rstd = rsqrtf(ss * (1.0f / 64.f) + EPSF);
            const float* gn = (isq ? p.q_norm_g : p.k_norm_g) + l * 64 + sub * 8;
            const f32x4 g0 = *(const f32x4*)gn, g1 = *(const f32x4*)(gn + 4);
#pragma unroll
            for (int e = 0; e < 8; ++e) x[e] = x[e] * rstd * (e < 4 ? g0[e] : g1[e - 4]);
            const float* rp = ROPE + (size_t)(pos >= 0 ? pos : 0) * 16;
#pragma unroll
            for (int e = 0; e < 8; ++e) {
                const float other = dpp_mov<0xB1>(x[e]);
                if (sub < 2) {
                    const float cs = rp[2 * e], sn = rp[2 * e + 1];
                    x[e] = sub == 0 ? x[e] * cs - other * sn : x[e] * cs + other * sn;
                }
            }
            u32x4 o;
            o.x = cvt_pk_bf16(x[0], x[1]); o.y = cvt_pk_bf16(x[2], x[3]); o.z = cvt_pk_bf16(x[4], x[5]); o.w = cvt_pk_bf16(x[6], x[7]);
            if (pos < 0) o = (u32x4){0u, 0u, 0u, 0u};
            *(u32x4*)dst = o;
            if (!isq && last && j >= 64) {
                float* op = p.out + O_PWK + ((size_t)((l * 2 + b) * 128 + (j - 64)) * 2 + kvh) * 64 + sub * 8;
                *(f32x4*)op = (f32x4){x[0], x[1], x[2], x[3]}; *(f32x4*)(op + 4) = (f32x4){x[4], x[5], x[6], x[7]};
            }
        }
    }
    for (int q = tid; q < 192 * 8; q += 512) {
        const int j = q >> 3, d0 = (q & 7) * 8, pos = q0 - 128 + j;
        u32x4 w = {0u, 0u, 0u, 0u};
        if (pos >= 0) w = *(const u32x4*)(Z + (size_t)(b * 8192 + pos) * ZS + C_AV + kvh * 64 + d0);
        const int pj = (j & ~31) + perm_pos(j & 31);
        bf16_t* d = sVt + d0 * 200 + pj;
        d[0] = (bf16_t)(w.x & 0xffff); d[200] = (bf16_t)(w.x >> 16); d[400] = (bf16_t)(w.y & 0xffff); d[600] = (bf16_t)(w.y >> 16);
        d[800] = (bf16_t)(w.z & 0xffff); d[1000] = (bf16_t)(w.z >> 16); d[1200] = (bf16_t)(w.w & 0xffff); d[1400] = (bf16_t)(w.w >> 16);
        if (last && j >= 64) {
            float* o = p.out + O_PWV + ((size_t)((l * 2 + b) * 128 + (j - 64)) * 2 + kvh) * 64 + d0;
            f32x4 a = {lo16(w.x), hi16(w.x), lo16(w.y), hi16(w.y)}, c = {lo16(w.z), hi16(w.z), lo16(w.w), hi16(w.w)};
            *(f32x4*)o = a; *(f32x4*)(o + 4) = c;
        }
    }
    __syncthreads();
    {
        const int hh = wid >> 1, t0 = (wid & 1) * 32, fr = lane & 15, fq = lane >> 4;
        bf16x8 qf[2][2];
#pragma unroll
        for (int qt = 0; qt < 2; ++qt)
#pragma unroll
            for (int ks = 0; ks < 2; ++ks) qf[qt][ks] = *(const bf16x8*)(sQ + (hh * 64 + t0 + 16 * qt + fr) * 72 + ks * 32 + fq * 8);
        u32x2 agv[2][4];
#pragma unroll
        for (int qt = 0; qt < 2; ++qt)
#pragma unroll
            for (int dt = 0; dt < 4; ++dt)
                agv[qt][dt] = *(const u32x2*)(Z + (size_t)(b * 8192 + q0 + t0 + 16 * qt + fr) * ZS + C_AG + (kvh * 4 + hh) * 64 + 16 * dt + 4 * fq);
        f32x4 s[10][2];
#pragma unroll
        for (int kt = 0; kt < 10; ++kt) {
            bf16x8 kf[2];
#pragma unroll
            for (int ks = 0; ks < 2; ++ks) kf[ks] = *(const bf16x8*)(sK + (t0 + 16 * kt + fr) * 72 + ks * 32 + fq * 8);
#pragma unroll
            for (int qt = 0; qt < 2; ++qt) {
                f32x4 a = {0.f, 0.f, 0.f, 0.f};
                a = __builtin_amdgcn_mfma_f32_16x16x32_bf16(kf[0], qf[qt][0], a, 0, 0, 0);
                a = __builtin_amdgcn_mfma_f32_16x16x32_bf16(kf[1], qf[qt][1], a, 0, 0, 0);
                s[kt][qt] = a;
            }
        }
        const float sink = p.sinks[l * 8 + kvh * 4 + hh];
        float inv[2];
#pragma unroll
        for (int qt = 0; qt < 2; ++qt) {
            const int t = t0 + 16 * qt + fr;
            float m = sink;
#pragma unroll
            for (int kt = 0; kt < 10; ++kt)
#pragma unroll
                for (int e = 0; e < 4; ++e) {
                    const int j = t0 + 16 * kt + 4 * fq + e;
                    const bool valid = (j >= t + 1) && (j <= t + 128) && (q0 - 128 + j >= 0);
                    const float v = valid ? s[kt][qt][e] * 0.125f : -INFINITY;
                    s[kt][qt][e] = v; m = fmaxf(m, v);
                }
            m = fmaxf(m, __shfl_xor(m, 16)); m = fmaxf(m, __shfl_xor(m, 32));
            float sum = 0.f;
#pragma unroll
            for (int kt = 0; kt < 10; ++kt)
#pragma unroll
                for (int e = 0; e < 4; ++e) { const float pv = __expf(s[kt][qt][e] - m); s[kt][qt][e] = pv; sum += pv; }
            sum += __shfl_xor(sum, 16); sum += __shfl_xor(sum, 32);
            inv[qt] = 1.0f / (sum + __expf(sink - m));
        }
        f32x4 o[4][2];
#pragma unroll
        for (int dt = 0; dt < 4; ++dt)
#pragma unroll
            for (int qt = 0; qt < 2; ++qt) o[dt][qt] = (f32x4){0.f, 0.f, 0.f, 0.f};
#pragma unroll
        for (int sp = 0; sp < 5; ++sp) {
            bf16x8 pf[2];
#pragma unroll
            for (int qt = 0; qt < 2; ++qt) {
                u32x4 w; w.x = cvt_pk_bf16(s[2 * sp][qt][0], s[2 * sp][qt][1]); w.y = cvt_pk_bf16(s[2 * sp][qt][2], s[2 * sp][qt][3]);
                w.z = cvt_pk_bf16(s[2 * sp + 1][qt][0], s[2 * sp + 1][qt][1]); w.w = cvt_pk_bf16(s[2 * sp + 1][qt][2], s[2 * sp + 1][qt][3]);
                pf[qt] = __builtin_bit_cast(bf16x8, w);
            }
#pragma unroll
            for (int dt = 0; dt < 4; ++dt) {
                const bf16x8 vf = *(const bf16x8*)(sVt + (16 * dt + fr) * 200 + t0 + 32 * sp + fq * 8);
#pragma unroll
                for (int qt = 0; qt < 2; ++qt) o[dt][qt] = __builtin_amdgcn_mfma_f32_16x16x32_bf16(vf, pf[qt], o[dt][qt], 0, 0, 0);
            }
        }
#pragma unroll
        for (int qt = 0; qt < 2; ++qt) {
            const size_t row = (size_t)(b * 8192 + q0 + t0 + 16 * qt + fr);
#pragma unroll
            for (int dt = 0; dt < 4; ++dt) {
                const int colx = (kvh * 4 + hh) * 64 + 16 * dt + 4 * fq;
                const u32x2 ag = agv[qt][dt];
                const f32x4 ov = o[dt][qt] * inv[qt];
                u32x2 w; w.x = cvt_pk_bf16(ov[0] * siluf(lo16(ag.x)), ov[1] * siluf(hi16(ag.x))); w.y = cvt_pk_bf16(ov[2] * siluf(lo16(ag.y)), ov[3] * siluf(hi16(ag.y)));
                *(u32x2*)((bf16_t*)(p.ws + W_MIX) + row * DM + colx) = w;
            }
        }
    }
    __syncthreads();
}

constexpr int NSPLIT = 4, SCAN_BLOCKS = 8 * NSPLIT;
constexpr int SL_W = 0, SL_QG = 64 * 272, SL_KD = SL_QG + 64 * 272, SL_AQK = SL_KD + 128 * 144, SL_BUF = SL_AQK + 64 * 144, SL_SS = 2 * SL_BUF, SL_TILE = SL_SS + 2 * 64 * 2 * 4,
              SL_TPITCH = 80, SL_END = SL_TILE + 2 * 64 * SL_TPITCH;
static_assert(SL_END <= LDS_USER, "scan LDS");
DI bf16x8 pack_b(const f32x4& a, const f32x4& b) {
    u32x4 w; w.x = cvt_pk_bf16(a[0], a[1]); w.y = cvt_pk_bf16(a[2], a[3]); w.z = cvt_pk_bf16(b[0], b[1]); w.w = cvt_pk_bf16(b[2], b[3]);
    return __builtin_bit_cast(bf16x8, w);
}
#define MFMA16(a, b, c) __builtin_amdgcn_mfma_f32_16x16x32_bf16((a), (b), (c), 0, 0, 0)
#define SFENCE() asm volatile("" ::: "memory")
DI void scan_chain(const Params& p, int l, int sb, const int n0, const int n1, unsigned char* smem, const int tid) {
    const int wid = tid >> 6, lane = tid & 63, fr = lane & 15, fq = lane >> 4;
    const int bh = sb & 7, cg = sb >> 3, b = bh >> 2, h = bh & 3;
    float* sSS = (float*)(smem + SL_SS);
    const int item0 = (b * 128) * 4 + h;
    if (wid >= 4) {
        const int lt = tid - 256;
        const unsigned char* gW = p.ws + W_PW; const unsigned char* gQ = p.ws + W_PQG; const unsigned char* gK = p.ws + W_PKD; const unsigned char* gA = p.ws + W_PAQK;
        const int r16 = lt >> 4, c16 = lt & 15, r8 = lt >> 3, c8 = lt & 7;
        const int dW = SL_W + r16 * 272 + c16 * 16, dQ = SL_QG + r16 * 272 + c16 * 16, dK = SL_KD + r8 * 144 + c8 * 16, dA = SL_AQK + r8 * 144 + c8 * 16;
        u32x4 st[14];
#define SCAN_LOAD(it_) do { const size_t i16 = (size_t)(it_) * 16384, i8 = (size_t)(it_) * 8192; \
            _Pragma("unroll") for (int i = 0; i < 4; ++i) { st[i] = *(const u32x4*)(gW + i16 + i * 4096 + lt * 16); st[4 + i] = *(const u32x4*)(gQ + i16 + i * 4096 + lt * 16); \
                st[8 + i] = *(const u32x4*)(gK + i16 + i * 4096 + lt * 16); } \
            st[12] = *(const u32x4*)(gA + i8 + lt * 16); st[13] = *(const u32x4*)(gA + i8 + 4096 + lt * 16); } while (0)
#define SCAN_STORE(bufp) do { unsigned char* bb_ = (bufp); \
            _Pragma("unroll") for (int i = 0; i < 4; ++i) { *(u32x4*)(bb_ + dW + i * 16 * 272) = st[i]; *(u32x4*)(bb_ + dQ + i * 16 * 272) = st[4 + i]; *(u32x4*)(bb_ + dK + i * 32 * 144) = st[8 + i]; } \
            *(u32x4*)(bb_ + dA) = st[12]; *(u32x4*)(bb_ + dA + 32 * 144) = st[13]; } while (0)
        SCAN_LOAD(item0 + 4 * n0);
        SCAN_STORE(smem);
        SCAN_LOAD(item0 + 4 * (n0 + 1));
        __syncthreads();
#pragma unroll 1
        for (int n = n0; n < n1; ++n) {
            if (n + 1 < n1) SCAN_STORE(smem + ((n + 1) & 1) * SL_BUF);
            SFENCE();
            if (n + 2 < n1) SCAN_LOAD(item0 + 4 * (n + 2));
            __syncthreads();
        }
#undef SCAN_LOAD
#undef SCAN_STORE
    } else if (wid >= 2) {
        const int ct = tid - 128;
        bf16_t* MIX = (bf16_t*)(p.ws + W_MIX);
        float* PSS = (float*)(p.ws + W_PSS);
        __syncthreads();
#pragma unroll 1
        for (int n = n0; n < n1; ++n) {
            __syncthreads();
            unsigned char* mixb = (unsigned char*)MIX + (size_t)(b * 8192 + n * 64) * (DM * 2);
            const float* ssw = sSS + (n & 1) * 128;
            const unsigned char* tile = smem + SL_TILE + (n & 1) * (64 * SL_TPITCH);
#pragma unroll
            for (int i = 0; i < 2; ++i) {
                const int q = ct + 128 * i, r = q >> 2, ch = q & 3;
                const u32x4 w = *(const u32x4*)(tile + r * SL_TPITCH + ch * 16);
                *(u32x4*)(mixb + (size_t)r * (DM * 2) + (512 + h * 128 + cg * 32 + ch * 8) * 2) = w;
                if (ch == 0) PSS[(size_t)(b * 8192 + n * 64 + r) * 16 + h * 4 + cg] = ssw[r * 2] + ssw[r * 2 + 1];
            }
        }
    } else {
        const int c0 = cg * 32 + wid * 16;
        const float* gU = (const float*)(p.ws + W_PU); const float* gGL = (const float*)(p.ws + W_PGL);
        const bf16_t* gG = (const bf16_t*)(p.ws + W_PG);
        float* Ssave = (float*)(p.ws + W_SST) + (size_t)bh * 16384;
        f32x4 S[8];
#pragma unroll
        for (int t = 0; t < 8; ++t)
#pragma unroll
            for (int e = 0; e < 4; ++e) S[t][e] = n0 ? Ssave[(size_t)(16 * t + 4 * fq + e) * 128 + c0 + fr] : 0.f;
        f32x4 un[4]; u32x4 dgn[2]; float gln = gGL[item0 + 4 * n0];
        const int lofs = ((c0 >> 4) * 64 + lane) * 16;
        {
            const f32x4* up = (const f32x4*)(gU + (size_t)(item0 + 4 * n0) * 8192 + lofs);
#pragma unroll
            for (int t = 0; t < 4; ++t) un[t] = up[t];
            const u32x4* gp = (const u32x4*)(gG + (size_t)(item0 + 4 * n0) * 8192 + lofs);
            dgn[0] = gp[0]; dgn[1] = gp[1];
        }
        __syncthreads();
        f32x4 vn[4]; u32x4 dgc[2]; float gl = gln;
#pragma unroll
        for (int t = 0; t < 4; ++t) vn[t] = un[t];
        dgc[0] = dgn[0]; dgc[1] = dgn[1];
        const int offW = fr * 272 + fq * 16, offA = fr * 144 + fq * 16;
#pragma unroll 1
        for (int n = n0; n < n1; ++n) {
            const int item = item0 + 4 * n;
            const unsigned char* buf = smem + (n & 1) * SL_BUF;
            float* ssw = sSS + (n & 1) * 128;
            unsigned char* tile = smem + SL_TILE + (n & 1) * (64 * SL_TPITCH);
            SFENCE();
            if (n + 1 < n1) {
                const f32x4* up = (const f32x4*)(gU + (size_t)(item + 4) * 8192 + lofs);
#pragma unroll
                for (int t = 0; t < 4; ++t) un[t] = up[t];
                const u32x4* gp = (const u32x4*)(gG + (size_t)(item + 4) * 8192 + lofs);
                dgn[0] = gp[0]; dgn[1] = gp[1];
                gln = gGL[item + 4];
            }
            SFENCE();
            bf16x8 Sb[4];
#pragma unroll
            for (int s = 0; s < 4; ++s) Sb[s] = pack_b(S[2 * s], S[2 * s + 1]);
            f32x4 o[4];
#pragma unroll
            for (int t = 0; t < 4; ++t) o[t] = (f32x4){0.f, 0.f, 0.f, 0.f};
            bf16x8 fa[8], fb[8];
#define LDWQ(dst, t_) _Pragma("unroll") for (int s = 0; s < 4; ++s) { dst[2 * s] = *(const bf16x8*)(buf + SL_W + (16 * (t_)) * 272 + offW + s * 64); dst[2 * s + 1] = *(const bf16x8*)(buf + SL_QG + (16 * (t_)) * 272 + offW + s * 64); }
#define MMWQ(src, t_) _Pragma("unroll") for (int s = 0; s < 4; ++s) { vn[t_] = MFMA16(src[2 * s], Sb[s], vn[t_]); o[t_] = MFMA16(src[2 * s + 1], Sb[s], o[t_]); }
#define LDAQ(dst) _Pragma("unroll") for (int t = 0; t < 4; ++t) _Pragma("unroll") for (int s = 0; s < 2; ++s) dst[2 * t + s] = *(const bf16x8*)(buf + SL_AQK + (16 * t) * 144 + offA + s * 64);
#define MMAQ(src) _Pragma("unroll") for (int t = 0; t < 4; ++t) _Pragma("unroll") for (int s = 0; s < 2; ++s) o[t] = MFMA16(src[2 * t + s], vb[s], o[t]);
#define LDKD(dst, tp) _Pragma("unroll") for (int t = 0; t < 4; ++t) _Pragma("unroll") for (int s = 0; s < 2; ++s) dst[2 * t + s] = *(const bf16x8*)(buf + SL_KD + (16 * (4 * (tp) + t)) * 144 + offA + s * 64);
#define MMKD(src, tp) _Pragma("unroll") for (int t = 0; t < 4; ++t) { S[4 * (tp) + t] = S[4 * (tp) + t] * gl; _Pragma("unroll") for (int s = 0; s < 2; ++s) S[4 * (tp) + t] = MFMA16(src[2 * t + s], vb[s], S[4 * (tp) + t]); }
#define SCHED() __builtin_amdgcn_sched_barrier(0)
            LDWQ(fa, 0); SFENCE(); SCHED();
            LDWQ(fb, 1); SCHED(); MMWQ(fa, 0); SFENCE(); SCHED();
            LDWQ(fa, 2); SCHED(); MMWQ(fb, 1); SFENCE(); SCHED();
            LDWQ(fb, 3); SCHED(); MMWQ(fa, 2); SFENCE(); SCHED();
            LDAQ(fa); SCHED(); MMWQ(fb, 3); SFENCE(); SCHED();
            bf16x8 vb[2];
            LDKD(fb, 0); SCHED();
            vb[0] = pack_b(vn[0], vn[1]); vb[1] = pack_b(vn[2], vn[3]);
            MMAQ(fa); SFENCE(); SCHED();
            LDKD(fa, 1); SCHED(); MMKD(fb, 0); SFENCE(); SCHED();
            MMKD(fa, 1); SFENCE(); SCHED();
#undef SCHED
#undef LDWQ
#undef MMWQ
#undef LDAQ
#undef MMAQ
#undef LDKD
#undef MMKD
            {
                float x[16];
#pragma unroll
                for (int t = 0; t < 4; ++t)
#pragma unroll
                    for (int e = 0; e < 4; ++e) x[t * 4 + e] = o[t][e] * o[t][e];
                const float tot = row16_transpose_reduce(x, fr);
                ssw[(16 * (fr >> 2) + 4 * fq + (fr & 3)) * 2 + wid] = tot;
            }
            {
                unsigned char* tp = tile + (4 * fq) * SL_TPITCH + (wid * 16 + fr) * 2;
#pragma unroll
                for (int t = 0; t < 4; ++t)
#pragma unroll
                    for (int e = 0; e < 4; ++e) {
                        const unsigned gw = dgc[t >> 1][(t & 1) * 2 + (e >> 1)];
                        const float gate = (e & 1) ? hi16(gw) : lo16(gw);
                        const float v = o[t][e] * gate;
                        *(bf16_t*)(tp + (16 * t + e) * SL_TPITCH) = (bf16_t)cvt_pk_bf16(v, v);
                    }
            }
            __syncthreads();
#pragma unroll
            for (int t = 0; t < 4; ++t) vn[t] = un[t];
            dgc[0] = dgn[0]; dgc[1] = dgn[1]; gl = gln;
        }
        float* Sout = n1 == 128 ? p.out + O_PDELTA + ((size_t)(l * 2 + b) * 4 + h) * 16384 : Ssave;
#pragma unroll
        for (int t = 0; t < 8; ++t)
#pragma unroll
            for (int e = 0; e < 4; ++e) Sout[(size_t)(16 * t + 4 * fq + e) * 128 + c0 + fr] = S[t][e];
    }
    __syncthreads();
}

DI void post_phase(const Params& p, const int tid) {
    bf16_t* MIX = (bf16_t*)(p.ws + W_MIX);
    const float* PSS = (const float*)(p.ws + W_PSS);
    for (int task = (blockIdx.x - 32) * 512 + tid; task < MP * 64; task += (gridDim.x - 32) * 512) {
        const int row = task >> 6, hc = task & 63, hh = hc >> 4, ch = hc & 15;
        const f32x4 ps = *(const f32x4*)(PSS + (size_t)row * 16 + hh * 4);
        const float rstd = rsqrtf(((ps[0] + ps[1]) + (ps[2] + ps[3])) * (1.0f / 128.f) + EPSF);
        u32x4* ptr = (u32x4*)(MIX + (size_t)row * DM + 512 + hh * 128 + ch * 8);
        const u32x4 w = *ptr;
        u32x4 ov;
        ov.x = cvt_pk_bf16(lo16(w.x) * rstd, hi16(w.x) * rstd); ov.y = cvt_pk_bf16(lo16(w.y) * rstd, hi16(w.y) * rstd);
        ov.z = cvt_pk_bf16(lo16(w.z) * rstd, hi16(w.z) * rstd); ov.w = cvt_pk_bf16(lo16(w.w) * rstd, hi16(w.w) * rstd);
        *ptr = ov;
    }
}

#ifndef REP0
#define REP0 1
#endif
#ifndef REP1
#define REP1 1
#endif
#ifndef REP2
#define REP2 1
#endif
#ifndef REP2A
#define REP2A 1
#endif
#ifndef REPP
#define REPP 1
#endif
#ifndef REPO
#define REPO 1
#endif
#ifndef REP1LIM
#define REP1LIM 1792
#endif
#ifndef PROBE_K
#define PROBE_K (-1)
#endif
#ifndef ITEM_PROBE
#define ITEM_PROBE (-1)
#endif
#ifndef A_EXTRA
#define A_EXTRA 0
#endif
#ifndef ITEM_GAP
#define ITEM_GAP 0
#endif
#ifndef PH_EN
#define PH_EN 1023
#endif
__global__ void __launch_bounds__(512, 2) hybrid_fwd(Params p) {
    extern __shared__ __attribute__((aligned(16))) unsigned char smem[];
    XcdBarrier xb;
    if (p.coop) {
        volatile XB_LAS unsigned* st = (volatile XB_LAS unsigned*)(XB_LAS unsigned char*)(smem + LDS_USER);
        if (threadIdx.x == 0) { st[0] = 0u; st[1] = 0u; }
        __syncthreads();
        xb = xcd_barrier_post((unsigned*)(p.ws + W_BAR), st);
    }
    for (int ph = p.phase_lo; ph < p.phase_hi; ++ph) {
        const bool probe_hit = (PROBE_K == 6) ? (ph == 0) : (PROBE_K >= 0 && ph > 0 && (ph - 1) % 6 == PROBE_K);
        unsigned long long probe_t0 = 0; if (probe_hit) probe_t0 = __builtin_amdgcn_s_memrealtime();
        int tid = threadIdx.x; asm volatile("" : "+v"(tid));
        if (ph == 0) {
            for (int rep = 0; rep < REPP; ++rep) { if (PH_EN & 1) phase0(p, smem, tid); }
        } else {
            const int l = (ph - 1) / 6, k6 = (ph - 1) % 6, k = k6 >= 4 ? k6 - 1 : k6;
            if (k6 == 0) {
                pg8::Gemm g; g.A = (const bf16_t*)(p.ws + W_XB); g.Bt = (const bf16_t*)(p.ws + W_WINT) + (size_t)l * NPAD * DM; g.M = MT; g.N = NPAD; g.K = DM; g.KL = DM;
                pg8::StaticOrder so; so.init(MT, NPAD, gridDim.x, blockIdx.x);
                EpiIn e; e.Z = (bf16_t*)(p.ws + W_Z); e.z8 = (float*)(p.ws + W_Z8); e.ss = (const float*)(p.ws + W_SS) + (size_t)l * MT * 16;
                if (PH_EN & 2) pg8::gemm_phase<EpiIn, pg8::StaticOrder, false>((PG8_LAS unsigned char*)smem, g, so, e, nullptr, tid);
                {
                    const int nunits = (MT / 256) * (NPAD / 256), full = nunits / (int)gridDim.x, rem = nunits - full * (int)gridDim.x;
                    if (l < 3 && rem > 0 && (int)blockIdx.x >= rem) { __syncthreads(); weights_layer(p, l + 1, (int)blockIdx.x - rem, (int)gridDim.x - rem, smem, tid); }
                }
            } else if (k6 <= 3) {
                const bool scanner = (k6 >= 2) && (blockIdx.x < SCAN_BLOCKS);
                if (scanner) { if (PH_EN & 32) scan_chain(p, l, blockIdx.x, k6 == 2 ? 0 : 64, k6 == 2 ? 64 : 128, smem, tid); }
                else {
                    const int wk = k6 == 1 ? (int)blockIdx.x : (int)blockIdx.x - SCAN_BLOCKS, nwk = k6 == 1 ? (int)gridDim.x : (int)gridDim.x - SCAN_BLOCKS;
                    if (k6 <= 2 && wk < 512) {
                        const int hf = k6 - 1;
                        PrepPre pre; float cw0[3][4], cw1[3][4];
                        {
                            const int c = 2 * (tid & 63), h = wk & 3;
#pragma unroll
                            for (int part = 0; part < 3; ++part)
#pragma unroll
                                for (int j = 0; j < 4; ++j) { const float* cp = p.conv_w + (size_t)(l * 4 + j) * 1536 + part * 512 + h * 128 + c; cw0[part][j] = cp[0]; cw1[part][j] = cp[1]; }
                        }
#define PREP_ITEM_OF(j_) ((((j_) >> 8) * 128 + 64 * hf + (((j_) >> 2) & 63)) * 4 + ((j_) & 3))
                        prep_preload(p, PREP_ITEM_OF(wk), tid, pre);
                        for (int j = wk; j < 512; j += nwk) {
                            asm volatile("" : "+v"(tid));
                            const int nj = j + nwk;
                            if (PH_EN & 4) prep_item(p, l, PREP_ITEM_OF(j), nj < 512 ? PREP_ITEM_OF(nj) : -1, pre, cw0, cw1, smem, tid);
                        }
#undef PREP_ITEM_OF
                    }
                    if (k6 == 3) {
                        unsigned* ctr = (unsigned*)(p.ws + W_CTR) + l;
                        volatile unsigned* qw = (volatile unsigned*)(smem + LDS_USER + 8);
                        for (;;) {
                            asm volatile("" : "+v"(tid));
                            if (tid == 0) *qw = atomicAdd(ctr, 1u);
                            __syncthreads();
                            const int it = __builtin_amdgcn_readfirstlane((int)*qw);
                            __syncthreads();
                            if (it >= 1280) break;
                            if (it < 256) { if (PH_EN & 16) sattn_item(p, l, it, smem, tid); }
                            else if (it < 768) { if (PH_EN & 64) pattn_item(p, l, it - 256, smem, tid); }
                            else { if (PH_EN & 8) sdelta_item(p, l, it - 768, smem, tid); }
                        }
                    }
                }
            } else {
                if (k == 3 && blockIdx.x >= 32) { if (PH_EN & 256) post_phase(p, tid); }
                else {
                    const int ks = blockIdx.x >> 3, j = blockIdx.x & 7;
                    pg8::Gemm g; g.A = (const bf16_t*)(p.ws + W_MIX); g.Bt = (const bf16_t*)(p.ws + W_WOUTT) + (size_t)l * DM * DM; g.M = MT; g.N = DM; g.K = DM; g.KL = DM;
                    OutOrder so; so.so.init(MP, DM, gridDim.x, blockIdx.x); so.fixed = (k == 3); so.fu.pm = 64 + (j >> 2); so.fu.pn = j & 3;
                    EpiOut e; e.xin_p = l == 0 ? p.x_prompt : p.out + O_YP; e.xin_s = l == 0 ? p.x_sample : p.out + O_YS; e.xout = p.out;
                    e.xb = (bf16_t*)(p.ws + W_XB); e.ssn = l < 3 ? (float*)(p.ws + W_SS) + (size_t)(l + 1) * MT * 16 : nullptr; e.part = nullptr;
                    if (k == 3) { g.A += ks * 256; g.Bt += ks * 256; g.KL = 256; e.part = (float*)(p.ws + W_PART) + (size_t)ks * MS * DM; }
                    else if ((tid >> 6) < 2) {
                        const int lane = tid & 63;
                        for (int srow = blockIdx.x * 2 + (tid >> 6); srow < MS; srow += gridDim.x * 2) {
                        const float* xs = e.xin_s + (size_t)srow * DM; const float* pp = (const float*)(p.ws + W_PART) + (size_t)srow * DM;
                        float* xo = p.out + O_YS + (size_t)srow * DM; bf16_t* xbo = e.xb + (size_t)(MP + srow) * DM;
                        float sq = 0.f;
#pragma unroll
                        for (int jj = 0; jj < 4; ++jj) {
                            const int cix = (lane + 64 * jj) * 4;
                            f32x4 v = *(const f32x4*)(xs + cix);
#pragma unroll
                            for (int q = 0; q < 4; ++q) v = v + *(const f32x4*)(pp + (size_t)q * MS * DM + cix);
                            *(f32x4*)(xo + cix) = v;
                            sq += v[0] * v[0] + v[1] * v[1] + v[2] * v[2] + v[3] * v[3];
                            if (e.ssn) { u32x2 o; o.x = cvt_pk_bf16(v[0], v[1]); o.y = cvt_pk_bf16(v[2], v[3]); *(u32x2*)(xbo + cix) = o; }
                        }
                        sq = wave_sum(sq);
                        if (e.ssn && lane < 16) e.ssn[(size_t)(MP + srow) * 16 + lane] = lane == 0 ? sq : 0.f;
                        }
                    }
                    if (PH_EN & 128) pg8::gemm_phase<EpiOut, OutOrder, false>((PG8_LAS unsigned char*)smem, g, so, e, nullptr, tid);
                }
            }
        }
        if (p.coop && ph + 1 < p.phase_hi) { if (p.coop == 2) cg::this_grid().sync(); else xcd_barrier(xb); }
        if (probe_hit) { const unsigned long long t1 = __builtin_amdgcn_s_memrealtime(); while (__builtin_amdgcn_s_memrealtime() - t1 < t1 - probe_t0) __builtin_amdgcn_s_sleep(8); }
    }
}

#ifndef N_LAUNCH_MODE
#define N_LAUNCH_MODE 1
#endif
extern "C" void kernel_launch(void* const* d_in, const int* in_sizes, int n_in, void* d_out, int out_size, void* d_ws, size_t ws_size, hipStream_t stream) {
    static int grid = 0;
    if (grid == 0) {
        if (n_in != 16 || ws_size < W_END) { fprintf(stderr, "kernel_launch: unexpected n_in %d or ws %zu (< %zu)\n", n_in, ws_size, (size_t)W_END); grid = -1; return; }
        int dev = 0, cus = 0;
        hipGetDevice(&dev); hipDeviceGetAttribute(&cus, hipDeviceAttributeMultiprocessorCount, dev);
        if (hipFuncSetAttribute((const void*)hybrid_fwd, hipFuncAttributeMaxDynamicSharedMemorySize, LDS_BYTES) != hipSuccess) { fprintf(stderr, "hipFuncSetAttribute failed\n"); grid = -1; return; }
        int per_cu = 0;
        if (hipOccupancyMaxActiveBlocksPerMultiprocessor(&per_cu, (const void*)hybrid_fwd, 512, LDS_BYTES) != hipSuccess || per_cu < 1) fprintf(stderr, "occupancy query says %d\n", per_cu);
        (void)hipGetLastError();
        grid = cus > 0 ? cus : 256;
    }
    if (grid < 0) return;
    Params p{};
    p.x_prompt = (const float*)d_in[0]; p.x_sample = (const float*)d_in[1]; p.cache_k = (const float*)d_in[2]; p.cache_v = (const float*)d_in[3];
    p.state_conv = (const float*)d_in[4]; p.state_delta = (const float*)d_in[5]; p.norm_g = (const float*)d_in[6]; p.w_in = (const float*)d_in[7];
    p.q_norm_g = (const float*)d_in[8]; p.k_norm_g = (const float*)d_in[9]; p.sinks = (const float*)d_in[10]; p.conv_w = (const float*)d_in[11];
    p.a_log = (const float*)d_in[12]; p.dt_bias = (const float*)d_in[13]; p.dn_norm_g = (const float*)d_in[14]; p.w_out = (const float*)d_in[15];
    p.out = (float*)d_out; p.ws = (unsigned char*)d_ws;
#if N_LAUNCH_MODE == 1
    hipMemsetAsync((unsigned char*)d_ws + W_BAR, 0, (size_t)XCD_BAR_WORDS * 4 + 64, stream);
    p.phase_lo = 0; p.phase_hi = 25; p.coop = 1;
    void* args[] = {&p};
    hipError_t e = hipLaunchCooperativeKernel((const void*)hybrid_fwd, dim3(grid), dim3(512), args, LDS_BYTES, stream);
    if (e != hipSuccess) fprintf(stderr, "cooperative launch failed: %s (grid %d)\n", hipGetErrorString(e), grid);
#else
    for (int ph = 0; ph < 25; ++ph) {
        p.phase_lo = ph; p.phase_hi = ph + 1; p.coop = 0;
        hipLaunchKernelGGL(hybrid_fwd, dim3(grid), dim3(512), LDS_BYTES, stream, p);
    }
#endif
}
```

```cpp
#include <hip/hip_runtime.h>
#include <hip/hip_cooperative_groups.h>
#include <cstdio>
#include <cstdint>
namespace cg = cooperative_groups;
#define DI __device__ __forceinline__
#define XB_TMO      128
#define XB_XCNT(j)  (256  + 64 * (j))
#define XB_XSUB(j)  (1280 + 64 * (j))
#define XB_XGEN(j)  (2304 + 64 * (j))
#define XB_TOP      3328
#define XB_TOPGEN   3392
#define XCD_BAR_WORDS 3456
#define XB_SPIN_CAP (1u << 18)
#define XB_LAS __attribute__((address_space(3)))

__device__ __forceinline__ unsigned xb_ld(unsigned* p)              { return __hip_atomic_load(p, __ATOMIC_RELAXED, __HIP_MEMORY_SCOPE_AGENT); }
__device__ __forceinline__ unsigned xb_add(unsigned* p, unsigned v) { return __hip_atomic_fetch_add(p, v, __ATOMIC_RELAXED, __HIP_MEMORY_SCOPE_AGENT); }
__device__ __forceinline__ unsigned xb_xcc_id() { return (unsigned)__builtin_amdgcn_s_getreg((3 << 11) | 20) & 0xFu; }
#define XB_SPIN(cond, bar) do { unsigned _sp = 0; while (cond) {   \
    if ((++_sp & 255u) == 0u) { if (xb_ld(&(bar)[XB_TMO])) break; if (_sp > XB_SPIN_CAP) { atomicAdd(&(bar)[XB_TMO], 1u); break; } } } } while (0)

struct XcdBarrier {
    unsigned* bar; unsigned x;
    volatile XB_LAS unsigned* st;
};

__device__ __forceinline__ XcdBarrier xcd_barrier_post(unsigned* bar, volatile XB_LAS unsigned* st) {
    XcdBarrier b; b.bar = bar; b.x = xb_xcc_id(); b.st = st;
    if (threadIdx.x == 0) (void)xb_add(&bar[XB_XCNT(b.x)], 1u);
    return b;
}
__device__ __forceinline__ void xcd_barrier_complete(unsigned* bar, unsigned x, unsigned& nloc, unsigned& nx) {
    const unsigned G = gridDim.x * gridDim.y * gridDim.z;
    unsigned sum, cnt, mine, sp = 0u;
    for (;;) {
        sum = 0u; cnt = 0u; mine = 0u;
#pragma unroll
        for (unsigned j = 0; j < 16; ++j) { const unsigned c = xb_ld(&bar[XB_XCNT(j)]); sum += c; cnt += (c > 0u) ? 1u : 0u; mine = (j == x) ? c : mine; }
        if (sum == G) break;
        __builtin_amdgcn_s_sleep(1);
        if ((++sp & 255u) == 0u) { if (xb_ld(&bar[XB_TMO])) break; if (sp > XB_SPIN_CAP) { atomicAdd(&bar[XB_TMO], 1u); break; } }
    }
    nloc = mine > 0u ? mine : 1u; nx = cnt > 0u ? cnt : 1u;
}

__device__ __forceinline__ void xcd_barrier(const XcdBarrier& b) {
    asm volatile("s_waitcnt vmcnt(0)" ::: "memory");
    __syncthreads();
    if (threadIdx.x == 0) {
        unsigned* bar = b.bar;
        __builtin_amdgcn_s_waitcnt(0);
        unsigned nloc = b.st[0], nx = b.st[1];
        if (nloc == 0u) { xcd_barrier_complete(bar, b.x, nloc, nx); b.st[0] = nloc; b.st[1] = nx; }
        const unsigned old = xb_add(&bar[XB_XSUB(b.x)], 1u);
        const unsigned gen = old / nloc;
        if (old + 1u == (gen + 1u) * nloc) {
            __builtin_amdgcn_fence(__ATOMIC_RELEASE, "agent");
            asm volatile("s_waitcnt vmcnt(0)" ::: "memory");
            const unsigned og = xb_add(&bar[XB_TOP], 1u);
            const unsigned tg = og / nx;
            if (og + 1u == (tg + 1u) * nx) xb_add(&bar[XB_TOPGEN], 1u);
            else XB_SPIN(xb_ld(&bar[XB_TOPGEN]) == tg, bar);
            __builtin_amdgcn_fence(__ATOMIC_ACQUIRE, "agent");
            xb_add(&bar[XB_XGEN(b.x)], 1u);
            asm volatile("s_waitcnt vmcnt(0)" ::: "memory");
        } else {
            XB_SPIN(xb_ld(&bar[XB_XGEN(b.x)]) == gen, bar);
            __builtin_amdgcn_fence(__ATOMIC_ACQUIRE, "agent");
            asm volatile("s_waitcnt vmcnt(0)" ::: "memory");
        }
    }
    __syncthreads();
}

namespace pg8 {
#define PG8_LAS __attribute__((address_space(3)))
typedef unsigned short bf16_t;
typedef short bf16x8 __attribute__((ext_vector_type(8)));
typedef float f32x4 __attribute__((ext_vector_type(4)));
typedef unsigned u32x4 __attribute__((ext_vector_type(4)));
constexpr int BM = 256, BK = 64, HALF = 128, HTB = HALF * BK * 2  , STAGE_BYTES = 8 * HTB, NXCD = 8, WGM = 8;

__host__ __device__ __forceinline__ int lds_byte(int r, int c) { const int st = (r >> 4) * 2 + (c >> 5), rr = r & 15, cc = c & 31, ob = rr * 64 + cc * 2; return st * 1024 + (ob ^ (((ob >> 9) & 1) << 5)); }
__host__ __device__ __forceinline__ void stage_rc(int b, int& R, int& C) { const int st = b / 1024, sb = b % 1024, swz = sb ^ (((sb >> 9) & 1) << 5); R = (st >> 1) * 16 + swz / 64; C = (st & 1) * 32 + (swz % 64) / 2; }
__host__ __device__ __forceinline__ int perm32(int rho) { const int n = rho >> 4, i = rho & 15; return 8 * (i >> 2) + 4 * n + (i & 3); }

struct Unit { int pm, pn; };
struct Gemm { const bf16_t* A; const bf16_t* Bt; int M, N, K, KL; };

struct StaticOrder {
    int nM, nN, nwg, G, c;
    __host__ __device__ void init(int M, int N, int G_, int c_) { nM = M / BM; nN = N / BM; nwg = nM * nN; G = G_; c = c_; }
    __host__ __device__ bool next(int i, Unit& u) const {
        const long L = (long)i * G + c; if (L >= nwg) return false;
        int wgid = (int)L; { const int q = nwg / NXCD, r = nwg % NXCD, xcd = wgid % NXCD, off = wgid / NXCD; wgid = (xcd < r ? xcd * (q + 1) : r * (q + 1) + (xcd - r) * q) + off; }
        const int nig = WGM * nN, gid = wgid / nig, fm = gid * WGM, gsz = (nM - fm) < WGM ? (nM - fm) : WGM;
        u.pm = fm + ((wgid % nig) % gsz); u.pn = (wgid % nig) / gsz; return true;
    }
    __device__ __forceinline__ void a_ready(const Unit&) const {}
    __device__ __forceinline__ void done(const Unit&) const {}
};
typedef __bf16 bf16x2_native __attribute__((ext_vector_type(2)));
typedef float f32x2_native __attribute__((ext_vector_type(2)));
__device__ __forceinline__ unsigned cvt_pk_bf16(float lo, float hi) { const f32x2_native v = {lo, hi}; return __builtin_bit_cast(unsigned, __builtin_convertvector(v, bf16x2_native)); }
template <class Epi, class Sched, bool STAMP = false>
__device__ __forceinline__ void gemm_phase(PG8_LAS unsigned char* lds, const Gemm g, const Sched& S, const Epi& E, unsigned long long* stamps, const int tid_in) {
    const int tid = tid_in, wid = __builtin_amdgcn_readfirstlane(tid >> 6), lane = tid & 63, wr = wid >> 2, wc = wid & 3, fr = lane & 15, fq = lane >> 4;
    const int K = g.K, nt = g.KL / BK;
    int ts_lo = 0, ts_hi = 0, nts = 0; const unsigned long long rt_entry = STAMP ? (unsigned long long)wall_clock64() : 0ull;
#define PG8_STAMP() do { if (STAMP && wid == 0 && nts < 64) { const unsigned long long _c = (unsigned long long)clock64(); \
        ts_lo = (lane == nts) ? (int)(unsigned)_c : ts_lo; ts_hi = (lane == nts) ? (int)(unsigned)(_c >> 32) : ts_hi; ++nts; } } while (0)
    PG8_STAMP();
    unsigned voffA[2], voffB[2];
#pragma unroll
    for (int i = 0; i < 2; ++i) { int R, C; stage_rc(tid * 16 + i * 8192, R, C); const int Rb = Epi::PERM ? ((R & ~31) + perm32(R & 31)) : R;
        voffA[i] = (unsigned)(R * K + C) * 2u; voffB[i] = (unsigned)(Rb * K + C) * 2u; }
    const size_t kstep = (size_t)(BK * 2);
    const size_t hstep = (size_t)HALF * K * 2;
    const size_t tstep = 2 * hstep;
    const unsigned ldsw = (unsigned)wid * 1024u;
    const int aoff = lds_byte(wr * 64 + fr, fq * 8), boff = lds_byte(wc * 32 + fr, fq * 8);
#define PG8_SA(b, h) (((b) * 2 + (h)) * HTB)
#define PG8_SB(b, h) ((4 + (b) * 2 + (h)) * HTB)
#define PG8_STAGE(bufoff, gbase, voff) do { _Pragma("unroll") for (int _i = 0; _i < 2; ++_i) \
        __builtin_amdgcn_global_load_lds((const unsigned*)((const char*)(gbase) + (voff)[_i]), (PG8_LAS unsigned*)(lds + (bufoff) + ldsw + _i * 8192), 16, 0, 0); } while (0)
#define PG8_LDA(dst, b, h) do { _Pragma("unroll") for (int m = 0; m < 4; ++m) _Pragma("unroll") for (int k = 0; k < 2; ++k) dst[m][k] = *(const PG8_LAS bf16x8*)(lds + PG8_SA(b, h) + aoff + m * 2048 + k * 1024); } while (0)
#define PG8_LDB(dst, b, h) do { _Pragma("unroll") for (int n = 0; n < 2; ++n) _Pragma("unroll") for (int k = 0; k < 2; ++k) dst[n][k] = *(const PG8_LAS bf16x8*)(lds + PG8_SB(b, h) + boff + n * 2048 + k * 1024); } while (0)
#define PG8_MMA(ai, bj, At, Bt) do { __builtin_amdgcn_s_setprio(1); _Pragma("unroll") for (int m = 0; m < 4; ++m) _Pragma("unroll") for (int n = 0; n < 2; ++n) _Pragma("unroll") for (int k = 0; k < 2; ++k) \
        acc[ai][bj][m][n] = __builtin_amdgcn_mfma_f32_16x16x32_bf16(Bt[n][k], At[m][k], acc[ai][bj][m][n], 0, 0, 0); __builtin_amdgcn_s_setprio(0); } while (0)
#define PG8_WAIT_V(n) asm volatile("s_waitcnt vmcnt(" #n ")" ::: "memory")
#define PG8_WAIT_L(n) asm volatile("s_waitcnt lgkmcnt(" #n ")" ::: "memory")
#define PG8_BAR __builtin_amdgcn_s_barrier()
#define PG8_SCHED __builtin_amdgcn_sched_barrier(0)
    Unit cur, nxt; int ui = 0;
    if (!S.next(0, cur)) return;
    f32x4 acc[2][2][4][2];
#pragma unroll
    for (int a = 0; a < 2; ++a)
#pragma unroll
        for (int b = 0; b < 2; ++b)
#pragma unroll
            for (int m = 0; m < 4; ++m)
#pragma unroll
                for (int n = 0; n < 2; ++n) acc[a][b][m][n] = (f32x4){0.f, 0.f, 0.f, 0.f};
    bf16x8 At[4][2], B0[2][2], B1[2][2];
    const char* cA = (const char*)g.A + (size_t)cur.pm * tstep; const char* cB = (const char*)g.Bt + (size_t)cur.pn * tstep;
    S.a_ready(cur);
    PG8_STAGE(PG8_SB(0, 0), cB, voffB); PG8_STAGE(PG8_SA(0, 0), cA, voffA); PG8_STAGE(PG8_SB(0, 1), cB + hstep, voffB); PG8_STAGE(PG8_SA(0, 1), cA + hstep, voffA);
    if (wr == 1) PG8_BAR;
    PG8_WAIT_V(4); PG8_BAR;
    PG8_STAGE(PG8_SB(1, 0), cB + kstep, voffB); PG8_STAGE(PG8_SA(1, 0), cA + kstep, voffA); PG8_STAGE(PG8_SB(1, 1), cB + hstep + kstep, voffB);
    PG8_WAIT_V(6); PG8_BAR;
    PG8_STAMP();
    for (;;) {
        const bool has_next = S.next(ui + 1, nxt);
        const char* nA = has_next ? (const char*)g.A + (size_t)nxt.pm * tstep : cA; const char* nB = has_next ? (const char*)g.Bt + (size_t)nxt.pn * tstep : cB;
        for (int t = 0; t < nt; t += 2) {
            const bool last = (t == nt - 2);
            const char* a1 = cA + (size_t)(t + 1) * kstep;
            const char* a2 = last ? nA : cA + (size_t)(t + 2) * kstep; const char* b2 = last ? nB : cB + (size_t)(t + 2) * kstep;
            const char* a3 = a2 + kstep; const char* b3 = b2 + kstep;
            if (last && has_next) S.a_ready(nxt);
            PG8_LDB(B0, 0, 0); PG8_SCHED; PG8_LDA(At, 0, 0); PG8_STAGE(PG8_SA(1, 1), a1 + hstep, voffA);
            PG8_WAIT_L(8); PG8_BAR; PG8_WAIT_L(0); PG8_MMA(0, 0, At, B0); PG8_BAR; PG8_SCHED;
            PG8_LDB(B1, 0, 1); PG8_STAGE(PG8_SB(0, 0), b2, voffB);
            PG8_BAR; PG8_WAIT_L(0); PG8_MMA(0, 1, At, B1); PG8_BAR;
            PG8_LDA(At, 0, 1); PG8_STAGE(PG8_SA(0, 0), a2, voffA);
            PG8_BAR; PG8_WAIT_L(0); PG8_MMA(1, 0, At, B0); PG8_BAR; PG8_SCHED;
            PG8_STAGE(PG8_SB(0, 1), b2 + hstep, voffB);
            PG8_WAIT_V(6); PG8_BAR; PG8_MMA(1, 1, At, B1); PG8_BAR;
            PG8_LDB(B0, 1, 0); PG8_SCHED; PG8_LDA(At, 1, 0); PG8_STAGE(PG8_SA(0, 1), a2 + hstep, voffA);
            PG8_WAIT_L(8); PG8_BAR; PG8_WAIT_L(0); PG8_MMA(0, 0, At, B0); PG8_BAR; PG8_SCHED;
            PG8_LDB(B1, 1, 1); PG8_STAGE(PG8_SB(1, 0), b3, voffB);
            PG8_BAR; PG8_WAIT_L(0); PG8_MMA(0, 1, At, B1); PG8_BAR;
            PG8_LDA(At, 1, 1); PG8_STAGE(PG8_SA(1, 0), a3, voffA);
            PG8_BAR; PG8_WAIT_L(0); PG8_MMA(1, 0, At, B0); PG8_BAR; PG8_SCHED;
            PG8_STAGE(PG8_SB(1, 1), b3 + hstep, voffB);
            PG8_WAIT_V(6); PG8_BAR; PG8_MMA(1, 1, At, B1); PG8_BAR;
        }
        PG8_STAMP();
        if constexpr (!Epi::AFTER_DRAIN) { E(acc, cur, wr, wc, fr, fq); S.done(cur); }
        PG8_STAMP();
        if (!has_next) break;
#pragma unroll
        for (int a = 0; a < 2; ++a)
#pragma unroll
            for (int b = 0; b < 2; ++b)
#pragma unroll
                for (int m = 0; m < 4; ++m)
#pragma unroll
                    for (int n = 0; n < 2; ++n) acc[a][b][m][n] = (f32x4){0.f, 0.f, 0.f, 0.f};
        cur = nxt; cA = nA; cB = nB; ++ui;
    }
    PG8_WAIT_V(0);
    if (wr == 0) PG8_BAR;
    PG8_BAR;
    if constexpr (Epi::AFTER_DRAIN) { E.fused(acc, cur, wr, wc, fr, fq, lds, wid, lane); S.done(cur); }
    PG8_STAMP();
    if (STAMP && wid == 0) { stamps[lane] = lane < nts ? (((unsigned long long)(unsigned)ts_hi << 32) | (unsigned)ts_lo) : 0ull;
        if (lane == 62) stamps[62] = rt_entry; if (lane == 63) stamps[63] = (unsigned long long)wall_clock64(); }
#undef PG8_STAMP
#undef PG8_SA
#undef PG8_SB
#undef PG8_STAGE
#undef PG8_LDA
#undef PG8_LDB
#undef PG8_MMA
#undef PG8_WAIT_V
#undef PG8_WAIT_L
#undef PG8_BAR
#undef PG8_SCHED
}
}

using pg8::bf16_t; using pg8::bf16x8; using pg8::f32x4; using pg8::u32x4; using pg8::cvt_pk_bf16;
typedef unsigned u32x2 __attribute__((ext_vector_type(2)));

constexpr int MP = 16384, MS = 512, MT = MP + MS, DM = 1024, ZS = 3328, NPAD = 3584, NIN = 3336;
constexpr float EPSF = 1e-6f;
constexpr int C_AQ = 0, C_AK = 512, C_AV = 640, C_AG = 768, C_DQKV = 1280, C_DG = 2816;
constexpr size_t O_YP = 0, O_YS = 16777216, O_PWK = 17301504, O_PWV = 17432576, O_PCONV = 17563648, O_PDELTA = 17600512,
                 O_SWK = 18124800, O_SWV = 26513408, O_SCONV = 34902016, O_SDELTA = 37261312;
constexpr size_t W_WINT = 0, W_WOUTT = W_WINT + (size_t)4 * NPAD * DM * 2, W_XB = W_WOUTT + (size_t)4 * DM * DM * 2,
                 W_Z = W_XB + (size_t)MT * DM * 2, W_Z8 = W_Z + (size_t)MT * ZS * 2, W_SS = W_Z8 + (size_t)MT * 8 * 4,
                 W_MIX = W_SS + (size_t)4 * MT * 16 * 4, W_PU = W_MIX + (size_t)MT * DM * 2, W_PW = W_PU + (size_t)1024 * 32768,
                 W_PQG = W_PW + (size_t)1024 * 16384, W_PKD = W_PQG + (size_t)1024 * 16384, W_PAQK = W_PKD + (size_t)1024 * 16384,
                 W_PGL = W_PAQK + (size_t)1024 * 8192, W_PG = W_PGL + 4096, W_PSS = W_PG + (size_t)1024 * 16384, W_ROPE = W_PSS + (size_t)MP * 16 * 4, W_SST = W_ROPE + (size_t)8196 * 16 * 4, W_PART = W_SST + (size_t)8 * 16384 * 4, W_BAR = W_PART + (size_t)4 * MS * DM * 4, W_CTR = W_BAR + (size_t)XCD_BAR_WORDS * 4, W_END = W_CTR + 64;
constexpr int LDS_USER = 162816, LDS_BYTES = LDS_USER + 16;

struct Params {
    const float *x_prompt, *x_sample, *cache_k, *cache_v, *state_conv, *state_delta, *norm_g, *w_in, *q_norm_g, *k_norm_g, *sinks, *conv_w, *a_log,
        *dt_bias, *dn_norm_g, *w_out;
    float* out; unsigned char* ws;
    int phase_lo, phase_hi, coop, pad;
};

DI float bf2f(bf16_t b) { return __uint_as_float(((unsigned)b) << 16); }
DI bf16_t f2bf(float f) { unsigned u = __float_as_uint(f); u += 0x7fffu + ((u >> 16) & 1u); return (bf16_t)(u >> 16); }
DI unsigned pk2(float lo, float hi) { return (unsigned)f2bf(lo) | ((unsigned)f2bf(hi) << 16); }
DI float lo16(unsigned w) { return __uint_as_float(w << 16); }
DI float hi16(unsigned w) { return __uint_as_float(w & 0xffff0000u); }
DI float wave_sum(float v) {
#pragma unroll
    for (int o = 1; o < 64; o <<= 1) v += __shfl_xor(v, o);
    return v;
}
DI float wave_max(float v) {
#pragma unroll
    for (int o = 1; o < 64; o <<= 1) v = fmaxf(v, __shfl_xor(v, o));
    return v;
}
DI float siluf(float x) { return x * __builtin_amdgcn_rcpf(1.0f + __expf(-x)); }
DI float sigmoidf_(float x) { return __builtin_amdgcn_rcpf(1.0f + __expf(-x)); }
DI float softplusf_(float x) { return x > 20.f ? x : log1pf(expf(x)); }
DI float rope_inv(int i) { return exp2f(-(float)i * (18.931568569324174f / 8.0f)); }
DI void sincos_rev(float ang, float& sn, float& cs) {
    double a = (double)ang * 0.15915494309189535; a -= rint(a);
    const float r = (float)a; sn = __builtin_amdgcn_sinf(r); cs = __builtin_amdgcn_cosf(r);
}
DI int opaque_zero() { int z; asm volatile("v_mov_b32 %0, 0" : "=v"(z)); return z; }
template <int CTRL> DI float dpp_mov(float x) { return __builtin_bit_cast(float, __builtin_amdgcn_update_dpp(0, __builtin_bit_cast(int, x), CTRL, 0xf, 0xf, true)); }
DI float row16_sum(float q) {
    q += dpp_mov<0xB1>(q); q += dpp_mov<0x4E>(q); q += dpp_mov<0x128>(q); q += dpp_mov<0x124>(q); return q;
}
DI float row16_transpose_reduce(const float (&x)[16], int fr) {
    float y8[8], y4[4], y2[2];
    const bool h8 = fr & 8, h4 = fr & 4, h2 = fr & 2, h1 = fr & 1;
#pragma unroll
    for (int i = 0; i < 8; ++i) { const float keep = h8 ? x[8 + i] : x[i], send = h8 ? x[i] : x[8 + i]; y8[i] = keep + dpp_mov<0x140>(send); }
#pragma unroll
    for (int i = 0; i < 4; ++i) { const float keep = h4 ? y8[4 + i] : y8[i], send = h4 ? y8[i] : y8[4 + i]; y4[i] = keep + dpp_mov<0x141>(send); }
#pragma unroll
    for (int i = 0; i < 2; ++i) { const float keep = h2 ? y4[2 + i] : y4[i], send = h2 ? y4[i] : y4[2 + i]; y2[i] = keep + dpp_mov<0x4E>(send); }
    const float keep = h1 ? y2[1] : y2[0], send = h1 ? y2[0] : y2[1];
    return keep + dpp_mov<0xB1>(send);
}
DI int perm_pos(int c32) { return ((c32 >> 2) & 3) * 8 + (c32 >> 4) * 4 + (c32 & 3); }

DI void transpose_item4(const float* W, int Nsrc, int nvalid, const float* g, bf16_t* WT, int kb, int nb4, float* tile, int tid) {
    const int k0 = kb * 64, n0 = nb4 * 256;
    {
        const int nn = tid & 63, kk0 = tid >> 6;
        float v[4][8];
#pragma unroll
        for (int q = 0; q < 4; ++q)
#pragma unroll
            for (int i = 0; i < 8; ++i) {
                const int n = n0 + 64 * q + nn;
                v[q][i] = W[(size_t)(k0 + kk0 + 8 * i) * Nsrc + (n < nvalid ? n : 0)];
                if (n >= nvalid) v[q][i] = 0.f;
            }
#pragma unroll
        for (int i = 0; i < 8; ++i) {
            const float gs = g ? g[k0 + kk0 + 8 * i] : 1.0f;
#pragma unroll
            for (int q = 0; q < 4; ++q) tile[q * (64 * 65) + (kk0 + 8 * i) * 65 + nn] = v[q][i] * gs;
        }
    }
    __syncthreads();
    {
        const int n = tid >> 3, c = tid & 7;
#pragma unroll
        for (int q = 0; q < 4; ++q) {
            const float* s = tile + q * (64 * 65) + (8 * c) * 65 + n;
            u32x4 o; o.x = cvt_pk_bf16(s[0], s[65]); o.y = cvt_pk_bf16(s[2 * 65], s[3 * 65]); o.z = cvt_pk_bf16(s[4 * 65], s[5 * 65]); o.w = cvt_pk_bf16(s[6 * 65], s[7 * 65]);
            *(u32x4*)(WT + (size_t)(n0 + 64 * q + n) * DM + k0 + 8 * c) = o;
        }
    }
    __syncthreads();
}

DI void weights_layer(const Params& p, int l, int w0, int nw, unsigned char* smem, const int tid) {
    float* tile = (float*)smem;
    for (int it = w0; it < 224 + 64; it += nw) {
        if (it < 224) { const int kb = it / 14, nb4 = it % 14;
            transpose_item4(p.w_in + (size_t)l * DM * NIN, NIN, NIN, p.norm_g + l * DM, (bf16_t*)(p.ws + W_WINT) + (size_t)l * NPAD * DM, kb, nb4, tile, tid); }
        else { const int r = it - 224, kb = r / 4, nb4 = r % 4;
            transpose_item4(p.w_out + (size_t)l * DM * DM, DM, DM, nullptr, (bf16_t*)(p.ws + W_WOUTT) + (size_t)l * DM * DM, kb, nb4, tile, tid); }
    }
}
DI void phase0(const Params& p, unsigned char* smem, const int tid) {
    const int wid = tid >> 6, lane = tid & 63;
    float* tile = (float*)smem;
    constexpr int I_IN = 1 * 16 * 14, I_OUT = 1 * 16 * 4, I_X = MT / 16;
    for (int t = blockIdx.x * 512 + tid; t < 8196 * 8; t += gridDim.x * 512) {
        const int pos = t >> 3, i = t & 7;
        float sn, cs; sincos_rev((float)pos * rope_inv(i), sn, cs);
        float* r = (float*)(p.ws + W_ROPE) + (size_t)t * 2; r[0] = cs; r[1] = sn;
    }
    for (int it = blockIdx.x; it < I_IN + I_OUT + I_X; it += gridDim.x) {
        if (it < I_IN) {
            const int l = it / (16 * 14), r = it % (16 * 14), kb = r / 14, nb4 = r % 14;
            transpose_item4(p.w_in + (size_t)l * DM * NIN, NIN, NIN, p.norm_g + l * DM, (bf16_t*)(p.ws + W_WINT) + (size_t)l * NPAD * DM, kb, nb4, tile, tid);
        } else if (it < I_IN + I_OUT) {
            const int r0 = it - I_IN, l = r0 / 64, r = r0 % 64, kb = r / 4, nb4 = r % 4;
            transpose_item4(p.w_out + (size_t)l * DM * DM, DM, DM, nullptr, (bf16_t*)(p.ws + W_WOUTT) + (size_t)l * DM * DM, kb, nb4, tile, tid);
        } else {
            const int row0 = (it - I_IN - I_OUT) * 16 + wid * 2;
            f32x4 v[2][4];
#pragma unroll
            for (int rr = 0; rr < 2; ++rr) {
                const int row = row0 + rr;
                const float* src = row < MP ? p.x_prompt + (size_t)row * DM : p.x_sample + (size_t)(row - MP) * DM;
#pragma unroll
                for (int j = 0; j < 4; ++j) v[rr][j] = *(const f32x4*)(src + (lane + 64 * j) * 4);
            }
#pragma unroll
            for (int rr = 0; rr < 2; ++rr) {
                const int row = row0 + rr;
                bf16_t* dst = (bf16_t*)(p.ws + W_XB) + (size_t)row * DM;
                float s = 0.f;
#pragma unroll
                for (int j = 0; j < 4; ++j) {
                    const f32x4 x = v[rr][j];
                    s += x[0] * x[0] + x[1] * x[1] + x[2] * x[2] + x[3] * x[3];
                    u32x2 o; o.x = cvt_pk_bf16(x[0], x[1]); o.y = cvt_pk_bf16(x[2], x[3]);
                    *(u32x2*)(dst + (lane + 64 * j) * 4) = o;
                }
                s = wave_sum(s);
                float* ss = (float*)(p.ws + W_SS);
                if (lane < 16) ss[(size_t)row * 16 + lane] = lane == 0 ? s : 0.f;
            }
        }
    }
}

struct EpiIn {
    static constexpr bool PERM = true, AFTER_DRAIN = false;
    bf16_t* Z; float* z8; const float* ss;
    DI void operator()(const f32x4 (&acc)[2][2][4][2], const pg8::Unit& u, int wr, int wc, int fr, int fq) const {
        const int row0 = u.pm * 256 + wr * 64 + fr;
#pragma unroll
        for (int ai = 0; ai < 2; ++ai)
#pragma unroll
            for (int m = 0; m < 4; ++m) {
                const int row = row0 + ai * 128 + m * 16;
                const f32x4* sp = (const f32x4*)(ss + (size_t)row * 16);
                const f32x4 s0 = sp[0], s1 = sp[1], s2 = sp[2], s3 = sp[3];
                const float ssum = (((s0[0] + s0[1]) + (s0[2] + s0[3])) + ((s1[0] + s1[1]) + (s1[2] + s1[3]))) + (((s2[0] + s2[1]) + (s2[2] + s2[3])) + ((s3[0] + s3[1]) + (s3[2] + s3[3])));
                const float rstd = rsqrtf(ssum * (1.0f / DM) + EPSF);
                if (u.pn < 13) {
                    bf16_t* rowp = Z + (size_t)row * ZS + u.pn * 256 + wc * 32 + 8 * fq;
#pragma unroll
                    for (int bj = 0; bj < 2; ++bj) {
                        const f32x4 v0 = acc[ai][bj][m][0] * rstd, v1 = acc[ai][bj][m][1] * rstd;
                        u32x4 w; w.x = cvt_pk_bf16(v0[0], v0[1]); w.y = cvt_pk_bf16(v0[2], v0[3]); w.z = cvt_pk_bf16(v1[0], v1[1]); w.w = cvt_pk_bf16(v1[2], v1[3]);
                        *(u32x4*)(rowp + bj * 128) = w;
                    }
                } else if (wc == 0 && fq == 0) {
                    *(f32x4*)(z8 + (size_t)row * 8) = acc[ai][0][m][0] * rstd;
                    *(f32x4*)(z8 + (size_t)row * 8 + 4) = acc[ai][0][m][1] * rstd;
                }
            }
    }
};
struct EpiOut {
    static constexpr bool PERM = false, AFTER_DRAIN = false;
    const float* xin_p; const float* xin_s; float* xout; bf16_t* xb; float* ssn; float* part;
    DI void operator()(const f32x4 (&acc)[2][2][4][2], const pg8::Unit& u, int wr, int wc, int fr, int fq) const {
        const int row0 = u.pm * 256 + wr * 64 + fr, col0 = u.pn * 256 + wc * 32 + 4 * fq;
        if (part) {
#pragma unroll
            for (int ai = 0; ai < 2; ++ai)
#pragma unroll
                for (int m = 0; m < 4; ++m) {
                    float* dst = part + (size_t)(row0 + ai * 128 + m * 16 - MP) * DM + col0;
#pragma unroll
                    for (int bj = 0; bj < 2; ++bj)
#pragma unroll
                        for (int n = 0; n < 2; ++n) *(f32x4*)(dst + bj * 128 + n * 16) = acc[ai][bj][m][n];
                }
            return;
        }
#pragma unroll
        for (int ai = 0; ai < 2; ++ai)
#pragma unroll
            for (int m = 0; m < 4; ++m) {
                const int row = row0 + ai * 128 + m * 16;
                const float* src = (row < MP ? xin_p + (size_t)row * DM : xin_s + (size_t)(row - MP) * DM) + col0;
                float* dst = xout + (size_t)row * DM + col0;
                bf16_t* dstb = xb + (size_t)row * DM + col0;
                float sq = 0.f;
#pragma unroll
                for (int bj = 0; bj < 2; ++bj)
#pragma unroll
                    for (int n = 0; n < 2; ++n) {
                        const f32x4 v = *(const f32x4*)(src + bj * 128 + n * 16) + acc[ai][bj][m][n];
                        *(f32x4*)(dst + bj * 128 + n * 16) = v;
                        if (ssn) {
                            u32x2 o; o.x = cvt_pk_bf16(v[0], v[1]); o.y = cvt_pk_bf16(v[2], v[3]);
                            *(u32x2*)(dstb + bj * 128 + n * 16) = o;
                            sq += v[0] * v[0] + v[1] * v[1] + v[2] * v[2] + v[3] * v[3];
                        }
                    }
                if (ssn) {
                    sq += __shfl_xor(sq, 16); sq += __shfl_xor(sq, 32);
                    if (fq == 0) ssn[(size_t)row * 16 + u.pn * 4 + wc] = sq;
                }
                asm volatile("" ::: "memory");
            }
    }
};

struct OutOrder {
    pg8::StaticOrder so; int fixed; pg8::Unit fu;
    DI bool next(int i, pg8::Unit& u) const { if (fixed) { if (i) return false; u = fu; return true; } return so.next(i, u); }
    DI void a_ready(const pg8::Unit&) const {}
    DI void done(const pg8::Unit&) const {}
};
constexpr int PL_G = 0, PL_BETA = 256, PL_EG = 512, PL_K = 1024, PL_Q = PL_K + 64 * 272, PL_RHS = PL_Q + 64 * 272, PL_A = PL_RHS + 64 * 256 * 4,
              PL_AQK = PL_A + 64 * 68 * 4, PL_KDT = PL_AQK + 64 * 72 * 2, PL_T = PL_KDT + 128 * 72 * 2, PL_END = PL_T + 4 * 16 * 16 * 4;
static_assert(PL_END <= LDS_BYTES, "prep LDS");

DI u32x4 perm_chunk_bf16(const bf16_t* row, int s, int g) {
    const u32x2 a = *(const u32x2*)(row + 32 * s + 4 * g), b = *(const u32x2*)(row + 32 * s + 16 + 4 * g);
    u32x4 o; o.x = a.x; o.y = a.y; o.z = b.x; o.w = b.y; return o;
}

struct PrepPre { unsigned xw[3][11]; float db, da; u32x4 dgv[2]; };
DI void prep_preload(const Params& p, int item, const int tid, PrepPre& pre) {
    const int wid = tid >> 6, lane = tid & 63, c = 2 * lane;
    const int h = item & 3, n = (item >> 2) & 127, b = item >> 9, R0 = b * 8192 + n * 64;
    const bf16_t* Z = (const bf16_t*)(p.ws + W_Z);
    const float* z8 = (const float*)(p.ws + W_Z8);
#pragma unroll
    for (int part = 0; part < 3; ++part) {
        const int ch = part * 512 + h * 128 + c;
#pragma unroll
        for (int i = 0; i < 11; ++i) {
            const int r = 8 * wid - 3 + i;
            const bool ok = (n * 64 + r >= 0);
            const unsigned w = *(const unsigned*)(Z + (size_t)(R0 + (ok ? r : 0)) * ZS + C_DQKV + ch);
            pre.xw[part][i] = ok ? w : 0u;
        }
    }
    pre.db = z8[(size_t)(R0 + lane) * 8 + h]; pre.da = z8[(size_t)(R0 + lane) * 8 + 4 + h];
#pragma unroll
    for (int i = 0; i < 2; ++i) { const int q = tid + 512 * i; pre.dgv[i] = *(const u32x4*)(Z + (size_t)(R0 + (q >> 4)) * ZS + C_DG + h * 128 + (q & 15) * 8); }
}
#ifndef PROBE_STAGE
#define PROBE_STAGE (-1)
#endif
#define PSTAGE(s_) do { if (PROBE_STAGE >= 0) { const unsigned long long t1_ = __builtin_amdgcn_s_memrealtime(); if (PROBE_STAGE == (s_)) { while (__builtin_amdgcn_s_memrealtime() - t1_ < t1_ - pst_) __builtin_amdgcn_s_sleep(4); } pst_ = __builtin_amdgcn_s_memrealtime(); } } while (0)
DI void prep_item(const Params& p, int l, int item, int next_item, PrepPre& pre, const float (&cw0)[3][4], const float (&cw1)[3][4], unsigned char* smem, const int tid) {
    const int wid = tid >> 6, lane = tid & 63;
    unsigned long long pst_ = (PROBE_STAGE >= 0) ? __builtin_amdgcn_s_memrealtime() : 0ull;
    const int h = item & 3, n = (item >> 2) & 127, b = item >> 9;
    const int R0 = b * 8192 + n * 64;
    float* sG = (float*)(smem + PL_G); float* sBeta = (float*)(smem + PL_BETA); float* sEG = (float*)(smem + PL_EG);
    bf16_t* sK = (bf16_t*)(smem + PL_K); bf16_t* sQ = (bf16_t*)(smem + PL_Q);
    float* sRhs = (float*)(smem + PL_RHS); float* sA = (float*)(smem + PL_A);
    bf16_t* sAqk = (bf16_t*)(smem + PL_AQK); bf16_t* sKdT = (bf16_t*)(smem + PL_KDT);
    const bf16_t* Z = (const bf16_t*)(p.ws + W_Z);
    const float* z8 = (const float*)(p.ws + W_Z8);
    const int c = 2 * lane;
    unsigned xw[3][11];
#pragma unroll
    for (int part = 0; part < 3; ++part)
#pragma unroll
        for (int i = 0; i < 11; ++i) xw[part][i] = pre.xw[part][i];
    const float pre_db = pre.db, pre_da = pre.da;
    const u32x4 dgl0 = pre.dgv[0], dgl1 = pre.dgv[1];
    if (wid == 0) {
        const float db = pre_db, da = pre_da;
        const float beta = sigmoidf_(db);
        const float spx = da + p.dt_bias[l * 4 + h], spy = __expf(spx);
        const float sp = spx > 15.f ? spx : (spy < 1e-3f ? spy * (1.0f - 0.5f * spy) : __logf(1.0f + spy));
        const float gg = -__expf(p.a_log[l * 4 + h]) * sp;
        float G = gg;
#pragma unroll
        for (int o = 1; o < 64; o <<= 1) { const float t = __shfl_up(G, o); if (lane >= o) G += t; }
        const float eG = __expf(G);
        sG[lane] = G; sBeta[lane] = beta; sEG[lane] = eG;
        if (lane == 63) ((float*)(p.ws + W_PGL))[item] = eG;
    }
    __syncthreads();
    PSTAGE(0);
    const int z0 = opaque_zero();
    const float G63 = sG[63 + z0];
    {
        bf16_t* Qg = (bf16_t*)(p.ws + W_PQG) + (size_t)item * 8192;
#pragma unroll
        for (int part = 0; part < 3; ++part) {
            float y0[8], y1[8], ssq[8];
#pragma unroll
            for (int tl = 0; tl < 8; ++tl) {
                float a0 = 0.f, a1 = 0.f;
#pragma unroll
                for (int j = 0; j < 4; ++j) { a0 += lo16(xw[part][tl + j]) * cw0[part][j]; a1 += hi16(xw[part][tl + j]) * cw1[part][j]; }
                y0[tl] = siluf(a0); y1[tl] = siluf(a1);
                ssq[tl] = y0[tl] * y0[tl] + y1[tl] * y1[tl];
            }
            if (part < 2) {
#pragma unroll
                for (int tl = 0; tl < 8; ++tl) ssq[tl] = row16_sum(ssq[tl]);
#pragma unroll
                for (int tl = 0; tl < 8; ++tl) ssq[tl] += __shfl_xor(ssq[tl], 16);
#pragma unroll
                for (int tl = 0; tl < 8; ++tl) ssq[tl] += __shfl_xor(ssq[tl], 32);
            }
#pragma unroll
            for (int tl = 0; tl < 8; ++tl) {
                const int t = 8 * wid + tl;
                if (part == 2) {
                    const float bt = sBeta[t + z0];
                    sRhs[t * 256 + c] = y0[tl] * bt; sRhs[t * 256 + c + 1] = y1[tl] * bt;
                } else {
                    float sc = rsqrtf(ssq[tl] + EPSF);
                    if (part == 0) {
                        sc *= 0.08838834764831845f;
                        const float q0 = y0[tl] * sc, q1 = y1[tl] * sc;
                        *(unsigned*)(sQ + t * 136 + c) = cvt_pk_bf16(q0, q1);
                        const float eg = sEG[t + z0];
                        *(unsigned*)(Qg + t * 128 + (c & ~31) + perm_pos(c & 31)) = cvt_pk_bf16(q0 * eg, q1 * eg);
                    } else {
                        const float k0 = y0[tl] * sc, k1 = y1[tl] * sc;
                        *(unsigned*)(sK + t * 136 + c) = cvt_pk_bf16(k0, k1);
                        const float be = sBeta[t + z0] * sEG[t + z0];
                        sRhs[t * 256 + 128 + c] = k0 * be; sRhs[t * 256 + 128 + c + 1] = k1 * be;
                        const float kd = __expf(G63 - sG[t + z0]);
                        const unsigned kw = cvt_pk_bf16(k0 * kd, k1 * kd);
                        sKdT[c * 72 + t] = (bf16_t)(kw & 0xffffu); sKdT[(c + 1) * 72 + t] = (bf16_t)(kw >> 16);
                    }
                }
            }
        }
        if (n == 127 && tid < 384) {
            const int part = tid >> 7, cc = tid & 127, ch = part * 512 + h * 128 + cc;
#pragma unroll
            for (int r = 0; r < 3; ++r)
                p.out[O_PCONV + ((size_t)(l * 2 + b) * 3 + r) * 1536 + ch] = bf2f(Z[(size_t)(b * 8192 + 8189 + r) * ZS + C_DQKV + ch]);
        }
    }
    __syncthreads();
    PSTAGE(1);
    {
        const int fr = lane & 15, fq = lane >> 4;
#pragma unroll
        for (int qq = 0; qq < 3; ++qq) {
            const int q = wid + 8 * qq;
            if (q < 20) {
                const int mat = q >= 10, r = mat ? q - 10 : q;
                const int ti = r >= 6 ? 3 : (r >= 3 ? 2 : (r >= 1 ? 1 : 0)), tj = r - (ti * (ti + 1)) / 2;
                const bf16_t* Arows = mat ? sQ : sK;
                f32x4 acc = {0.f, 0.f, 0.f, 0.f};
#pragma unroll
                for (int ks = 0; ks < 4; ++ks) {
                    const bf16x8 afr = *(const bf16x8*)(Arows + (16 * ti + fr) * 136 + ks * 32 + fq * 8);
                    const bf16x8 bfr = *(const bf16x8*)(sK + (16 * tj + fr) * 136 + ks * 32 + fq * 8);
                    acc = __builtin_amdgcn_mfma_f32_16x16x32_bf16(afr, bfr, acc, 0, 0, 0);
                }
                const int j = 16 * tj + fr; const float Gj = sG[j];
#pragma unroll
                for (int e = 0; e < 4; ++e) {
                    const int i = 16 * ti + 4 * fq + e;
                    const float dec = __expf(sG[i] - Gj);
                    if (mat == 0) sA[i * 68 + j] = (i > j) ? -(acc[e] * sBeta[i] * dec) : 0.f;
                    else sAqk[i * 72 + j] = (i >= j) ? f2bf(acc[e] * dec) : (bf16_t)0;
                }
            }
        }
        for (int z = tid; z < 6 * 64; z += 512) {
            const int tz = z >> 6, w4 = z & 63, ti = tz < 3 ? 0 : (tz < 5 ? 1 : 2), tj = tz < 3 ? tz + 1 : (tz < 5 ? tz - 1 : 3);
            const int i = 16 * ti + (w4 >> 2), j0 = 16 * tj + (w4 & 3) * 4;
            *(u32x2*)(sAqk + i * 72 + j0) = (u32x2){0u, 0u};
        }
    }
    __syncthreads();
    PSTAGE(2);
    if (next_item >= 0) prep_preload(p, next_item, tid, pre);
    {
#pragma unroll
        for (int i = 0; i < 2; ++i) {
            const int q = tid + 512 * i, r = q >> 4, c8 = (q & 15) * 8;
            const u32x4 w = i ? dgl1 : dgl0;
            const f32x4 g0 = *(const f32x4*)(p.dn_norm_g + l * 128 + c8), g1 = *(const f32x4*)(p.dn_norm_g + l * 128 + c8 + 4);
            u32x4 o;
            o.x = cvt_pk_bf16(siluf(lo16(w.x)) * g0[0], siluf(hi16(w.x)) * g0[1]); o.y = cvt_pk_bf16(siluf(lo16(w.y)) * g0[2], siluf(hi16(w.y)) * g0[3]);
            o.z = cvt_pk_bf16(siluf(lo16(w.z)) * g1[0], siluf(hi16(w.z)) * g1[1]); o.w = cvt_pk_bf16(siluf(lo16(w.w)) * g1[2], siluf(hi16(w.w)) * g1[3]);
            *(u32x4*)(sK + r * 136 + c8) = o;
        }
    }
    {
        const int fr = lane & 15, fq = lane >> 4, t2 = tid - 256;
        bf16_t* Aq = (bf16_t*)(p.ws + W_PAQK) + (size_t)item * 4096;
        bf16_t* Kd = (bf16_t*)(p.ws + W_PKD) + (size_t)item * 8192;
        float* sT = (float*)(smem + PL_T);
        if (tid < 64) {
            const int I = tid >> 4, cidx = tid & 15;
            const float* Ab = sA + (16 * I) * 68 + 16 * I;
            float tcol[16];
#pragma unroll
            for (int i = 0; i < 16; ++i) {
                float a0 = (i == cidx) ? 1.0f : 0.0f, a1 = 0.f;
#pragma unroll
                for (int j4 = 0; j4 < (i + 3) / 4; ++j4) {
                    const f32x4 av = *(const f32x4*)(Ab + i * 68 + 4 * j4);
#pragma unroll
                    for (int e = 0; e < 4; ++e) if (4 * j4 + e < i) { if (e & 1) a1 += av[e] * tcol[4 * j4 + e]; else a0 += av[e] * tcol[4 * j4 + e]; }
                }
                tcol[i] = a0 + a1;
                sT[(I * 16 + i) * 16 + cidx] = tcol[i];
            }
        } else if (tid >= 256) {
#pragma unroll
            for (int i2 = 0; i2 < 2; ++i2) { const int q = t2 + 256 * i2, r = q >> 3, c8 = q & 7, s = c8 >> 2, g = c8 & 3; *(u32x4*)(Aq + r * 64 + 32 * s + 8 * g) = perm_chunk_bf16(sAqk + r * 72, s, g); }
#pragma unroll
            for (int i2 = 0; i2 < 4; ++i2) { const int q = t2 + 256 * i2, r = q >> 3, c8 = q & 7, s = c8 >> 2, g = c8 & 3; *(u32x4*)(Kd + r * 64 + 32 * s + 8 * g) = perm_chunk_bf16(sKdT + r * 72, s, g); }
        }
        __syncthreads();
        {
            f32x4 dacc[2];
#pragma unroll
            for (int uu = 0; uu < 2; ++uu) {
                const int CT = wid + 8 * uu;
                dacc[uu] = (f32x4){0.f, 0.f, 0.f, 0.f};
#pragma unroll
                for (int ks = 0; ks < 4; ++ks) {
                    const float av = sT[fr * 16 + 4 * ks + fq];
                    const float bv = sRhs[(4 * ks + fq) * 256 + 16 * CT + fr];
                    dacc[uu] = __builtin_amdgcn_mfma_f32_16x16x4f32(av, bv, dacc[uu], 0, 0, 0);
                }
            }
#pragma unroll
            for (int uu = 0; uu < 2; ++uu) {
                float* ct = sRhs + (4 * fq) * 256 + 16 * (wid + 8 * uu) + fr;
                ct[0] = dacc[uu][0]; ct[256] = dacc[uu][1]; ct[512] = dacc[uu][2]; ct[768] = dacc[uu][3];
            }
        }
        __syncthreads();
#pragma unroll
        for (int I = 0; I < 3; ++I) {
#pragma unroll
            for (int uu = 0; uu < (3 - I) * 2; ++uu) {
                const int u = wid + 8 * uu;
                const int RT = I + 1 + (u >> 4), CT = u & 15;
                float* ct = sRhs + (16 * RT + 4 * fq) * 256 + 16 * CT + fr;
                f32x4 cacc = {ct[0], ct[256], ct[512], ct[768]};
#pragma unroll
                for (int ks = 0; ks < 4; ++ks) {
                    const float av = sA[(16 * RT + fr) * 68 + 16 * I + 4 * ks + fq];
                    const float bv = sRhs[(16 * I + 4 * ks + fq) * 256 + 16 * CT + fr];
                    cacc = __builtin_amdgcn_mfma_f32_16x16x4f32(av, bv, cacc, 0, 0, 0);
                }
                if (uu < 2) {
                    f32x4 xacc = {0.f, 0.f, 0.f, 0.f};
#pragma unroll
                    for (int e = 0; e < 4; ++e) xacc = __builtin_amdgcn_mfma_f32_16x16x4f32(sT[((I + 1) * 16 + fr) * 16 + 4 * fq + e], cacc[e], xacc, 0, 0, 0);
                    cacc = xacc;
                }
                ct[0] = cacc[0]; ct[256] = cacc[1]; ct[512] = cacc[2]; ct[768] = cacc[3];
            }
            __syncthreads();
        }
    }
    PSTAGE(3);
    {
        float* U = (float*)(p.ws + W_PU) + (size_t)item * 8192;
        bf16_t* Gt4 = (bf16_t*)(p.ws + W_PG) + (size_t)item * 8192;
#pragma unroll
        for (int i = 0; i < 4; ++i) {
            const int q = tid + 512 * i, cc = q & 127, tf = q >> 7, t = tf >> 2, fq = tf & 3;
            const int di = (((cc >> 4) * 64 + fq * 16 + (cc & 15)) * 16 + t * 4);
            f32x4 uv;
#pragma unroll
            for (int e = 0; e < 4; ++e) uv[e] = sRhs[(16 * t + 4 * fq + e) * 256 + cc];
            *(f32x4*)(U + di) = uv;
            const bf16_t* gt = sK + (16 * t + 4 * fq) * 136 + cc;
            u32x2 gw; gw.x = (unsigned)gt[0] | ((unsigned)gt[136] << 16); gw.y = (unsigned)gt[272] | ((unsigned)gt[408] << 16);
            *(u32x2*)(Gt4 + di) = gw;
        }
        bf16_t* Wn = (bf16_t*)(p.ws + W_PW) + (size_t)item * 8192;
#pragma unroll
        for (int i = 0; i < 2; ++i) {
            const int q = tid + 512 * i, r = q >> 4, c16 = q & 15, s = c16 >> 2, g = c16 & 3;
            const f32x4 a = *(const f32x4*)(sRhs + r * 256 + 128 + 32 * s + 4 * g), bb = *(const f32x4*)(sRhs + r * 256 + 128 + 32 * s + 16 + 4 * g);
            u32x4 o; o.x = cvt_pk_bf16(-a[0], -a[1]); o.y = cvt_pk_bf16(-a[2], -a[3]); o.z = cvt_pk_bf16(-bb[0], -bb[1]); o.w = cvt_pk_bf16(-bb[2], -bb[3]);
            *(u32x4*)(Wn + r * 128 + 32 * s + 8 * g) = o;
        }
    }
    __syncthreads();
    PSTAGE(4);
}

DI void sdelta_item(const Params& p, int l, int item, unsigned char* smem, const int tid) {
    const int wid = tid >> 6, lane = tid & 63;
    const int h = item & 3, b = item >> 2;
    float* sY = (float*)smem;
    float* sRed = sY + 3 * 4 * 128;
    float* sBG = sRed + 4 * 2 * 4 * 128;
    const bf16_t* Z = (const bf16_t*)(p.ws + W_Z);
    const float* z8 = (const float*)(p.ws + W_Z8);
    const int RS = MP + b * 4;
    const int v = tid & 127, kq = tid >> 7;
    float S[32];
    const float* S0 = p.state_delta + ((size_t)(l * 128 + b) * 4 + h) * 16384;
#pragma unroll
    for (int i = 0; i < 32; ++i) S[i] = __builtin_nontemporal_load(S0 + (size_t)(kq * 32 + i) * 128 + v);
    if (tid < 384) {
        const int part = tid >> 7, c = tid & 127, ch = part * 512 + h * 128 + c;
        float xx[7];
#pragma unroll
        for (int r = 0; r < 3; ++r) xx[r] = p.state_conv[((size_t)(l * 128 + b) * 3 + r) * 1536 + ch];
#pragma unroll
        for (int t = 0; t < 4; ++t) xx[3 + t] = bf2f(Z[(size_t)(RS + t) * ZS + C_DQKV + ch]);
#pragma unroll
        for (int r = 0; r < 3; ++r) p.out[O_SCONV + ((size_t)(l * 128 + b) * 3 + r) * 1536 + ch] = xx[4 + r];
        float cw[4];
#pragma unroll
        for (int j = 0; j < 4; ++j) cw[j] = p.conv_w[(size_t)(l * 4 + j) * 1536 + ch];
#pragma unroll
        for (int t = 0; t < 4; ++t) {
            float y = 0.f;
#pragma unroll
            for (int j = 0; j < 4; ++j) y += xx[t + j] * cw[j];
            sY[(part * 4 + t) * 128 + c] = siluf(y);
        }
    } else if (tid < 388) {
        const int t = tid - 384;
        const float db = z8[(size_t)(RS + t) * 8 + h], da = z8[(size_t)(RS + t) * 8 + 4 + h];
        sBG[t] = sigmoidf_(db);
        sBG[4 + t] = expf(-expf(p.a_log[l * 4 + h]) * softplusf_(da + p.dt_bias[l * 4 + h]));
    }
    __syncthreads();
    {
        float* row = sY + wid * 128;
        const float a0 = row[lane], a1 = row[lane + 64];
        float sc = rsqrtf(wave_sum(a0 * a0 + a1 * a1) + EPSF);
        if (wid < 4) sc *= 0.08838834764831845f;
        row[lane] = a0 * sc; row[lane + 64] = a1 * sc;
    }
    __syncthreads();
#pragma unroll 1
    for (int t = 0; t < 4; ++t) {
        const float a = sBG[4 + t], beta = sBG[t];
        const float* qv = sY + (0 * 4 + t) * 128 + kq * 32; const float* kv = sY + (1 * 4 + t) * 128 + kq * 32;
        float part = 0.f;
#pragma unroll
        for (int i = 0; i < 32; ++i) { S[i] *= a; part += kv[i] * S[i]; }
        float* red = sRed + (t * 2 + 0) * 512;
        red[kq * 128 + v] = part;
        __syncthreads();
        const float kS = red[v] + red[128 + v] + red[256 + v] + red[384 + v];
        const float vnew = (sY[(2 * 4 + t) * 128 + v] - kS) * beta;
        float po = 0.f;
#pragma unroll
        for (int i = 0; i < 32; ++i) { S[i] += kv[i] * vnew; po += qv[i] * S[i]; }
        float* red2 = sRed + (t * 2 + 1) * 512;
        red2[kq * 128 + v] = po;
    }
    __syncthreads();
    float* Sout = p.out + O_SDELTA + ((size_t)(l * 128 + b) * 4 + h) * 16384;
#pragma unroll
    for (int i = 0; i < 32; ++i) __builtin_nontemporal_store(S[i], Sout + (size_t)(kq * 32 + i) * 128 + v);
    if (wid < 4) {
        const int t = wid;
        const float* red2 = sRed + (t * 2 + 1) * 512;
        float o0 = red2[lane] + red2[128 + lane] + red2[256 + lane] + red2[384 + lane];
        float o1 = red2[lane + 64] + red2[128 + lane + 64] + red2[256 + lane + 64] + red2[384 + lane + 64];
        const float rstd = rsqrtf(wave_sum(o0 * o0 + o1 * o1) * (1.0f / 128.f) + EPSF);
        const bf16_t* dg = Z + (size_t)(RS + t) * ZS + C_DG + h * 128;
        bf16_t* mix = (bf16_t*)(p.ws + W_MIX) + (size_t)(RS + t) * DM + 512 + h * 128;
        mix[lane] = f2bf(o0 * rstd * p.dn_norm_g[l * 128 + lane] * siluf(bf2f(dg[lane])));
        mix[lane + 64] = f2bf(o1 * rstd * p.dn_norm_g[l * 128 + lane + 64] * siluf(bf2f(dg[lane + 64])));
    }
    __syncthreads();
}

DI void sattn_item(const Params& p, int l, int item, unsigned char* smem, const int tid) {
    const int wid = tid >> 6, lane = tid & 63;
    const int kvh = item & 1, b = item >> 1;
    float* sK = (float*)smem;
    float* sV = sK + 132 * 65;
    float* sQ = sV + 132 * 64;
    float* sP = sQ + 16 * 64;
    const bf16_t* Z = (const bf16_t*)(p.ws + W_Z);
    const int RS = MP + b * 4;
    const float* ck = p.cache_k + (size_t)(l * 128 + b) * 128 * 128 + kvh * 64;
    const float* cv = p.cache_v + (size_t)(l * 128 + b) * 128 * 128 + kvh * 64;
    float* ok = p.out + O_SWK + (size_t)(l * 128 + b) * 128 * 128 + kvh * 64;
    float* ov = p.out + O_SWV + (size_t)(l * 128 + b) * 128 * 128 + kvh * 64;
    for (int q = tid; q < 128 * 16; q += 512) {
        const int i = q >> 4, d4 = (q & 15) * 4;
        const f32x4 kk = __builtin_nontemporal_load((const f32x4*)(ck + (size_t)i * 128 + d4)), vv = __builtin_nontemporal_load((const f32x4*)(cv + (size_t)i * 128 + d4));
        sK[i * 65 + d4] = kk[0]; sK[i * 65 + d4 + 1] = kk[1]; sK[i * 65 + d4 + 2] = kk[2]; sK[i * 65 + d4 + 3] = kk[3];
        *(f32x4*)(sV + i * 64 + d4) = vv;
        if (i >= 4) { __builtin_nontemporal_store(kk, (f32x4*)(ok + (size_t)(i - 4) * 128 + d4)); __builtin_nontemporal_store(vv, (f32x4*)(ov + (size_t)(i - 4) * 128 + d4)); }
    }
    for (int r = wid; r < 24; r += 8) {
        if (r >= 4 && r < 8) {
            const int t = r - 4;
            const float x = bf2f(Z[(size_t)(RS + t) * ZS + C_AV + kvh * 64 + lane]);
            sV[(128 + t) * 64 + lane] = x; ov[(size_t)(124 + t) * 128 + lane] = x;
        } else {
            const bool isk = r < 4; const int t = isk ? r : (r - 8) >> 2, hh = isk ? 0 : (r - 8) & 3;
            const float x = bf2f(Z[(size_t)(RS + t) * ZS + (isk ? C_AK + kvh * 64 : C_AQ + (kvh * 4 + hh) * 64) + lane]);
            const float rstd = rsqrtf(wave_sum(x * x) * (1.0f / 64.f) + EPSF);
            float y = x * rstd * (isk ? p.k_norm_g[l * 64 + lane] : p.q_norm_g[l * 64 + lane]);
            const float yp = __shfl_xor(y, 8);
            if (lane < 16) {
                const float ang = (float)(8192 + t) * rope_inv(lane & 7);
                float cs, sn; sincos_rev(ang, sn, cs);
                y = lane < 8 ? y * cs - yp * sn : y * cs + yp * sn;
            }
            if (isk) { sK[(128 + t) * 65 + lane] = y; ok[(size_t)(124 + t) * 128 + lane] = y; }
            else sQ[(t * 4 + hh) * 64 + lane] = y;
        }
    }
    __syncthreads();
    for (int q = tid; q < 16 * 132; q += 512) {
        const int r = q / 132, key = q % 132, t = r >> 2;
        float s = 0.f;
#pragma unroll 16
        for (int d = 0; d < 64; ++d) s += sQ[r * 64 + d] * sK[key * 65 + d];
        const bool valid = key < 128 ? (key >= t + 1) : (key - 128 <= t);
        sP[r * 136 + key] = valid ? s * 0.125f : -INFINITY;
    }
    __syncthreads();
    for (int r = wid; r < 16; r += 8) {
        const float sink = p.sinks[l * 8 + kvh * 4 + (r & 3)];
        const float s0 = sP[r * 136 + lane], s1 = sP[r * 136 + lane + 64], s2 = lane < 4 ? sP[r * 136 + lane + 128] : -INFINITY;
        const float m = fmaxf(wave_max(fmaxf(fmaxf(s0, s1), s2)), sink);
        const float p0 = __expf(s0 - m), p1 = __expf(s1 - m), p2 = lane < 4 ? __expf(s2 - m) : 0.f;
        const float den = wave_sum(p0 + p1 + p2) + __expf(sink - m);
        const float inv = 1.0f / den;
        sP[r * 136 + lane] = p0 * inv; sP[r * 136 + lane + 64] = p1 * inv; if (lane < 4) sP[r * 136 + lane + 128] = p2 * inv;
    }
    __syncthreads();
    for (int q = tid; q < 16 * 64; q += 512) {
        const int r = q >> 6, d = q & 63, t = r >> 2, hh = r & 3;
        float o = 0.f;
#pragma unroll 4
        for (int key = 0; key < 132; ++key) o += sP[r * 136 + key] * sV[key * 64 + d];
        const int colx = (kvh * 4 + hh) * 64 + d;
        const float ag = bf2f(Z[(size_t)(RS + t) * ZS + C_AG + colx]);
        ((bf16_t*)(p.ws + W_MIX))[(size_t)(RS + t) * DM + colx] = f2bf(o * siluf(ag));
    }
    __syncthreads();
}

constexpr int AL_Q = 0, AL_K = AL_Q + 4 * 64 * 144, AL_VT = AL_K + 192 * 144, AL_END = AL_VT + 64 * 400;
static_assert(AL_END <= LDS_BYTES, "attn LDS");
DI void pattn_item(const Params& p, int l, int item, unsigned char* smem, const int tid) {
    const int wid = tid >> 6, lane = tid & 63;
    const int kvh = item & 1, qb = (item >> 1) & 127, b = item >> 8;
    const int q0 = qb * 64;
    bf16_t* sQ = (bf16_t*)(smem + AL_Q); bf16_t* sK = (bf16_t*)(smem + AL_K); bf16_t* sVt = (bf16_t*)(smem + AL_VT);
    const bf16_t* Z = (const bf16_t*)(p.ws + W_Z);
    const bool last = (qb == 127);
    {
        const float* ROPE = (const float*)(p.ws + W_ROPE);
        const int sub = tid & 7;
        u32x4 raw[7];
#pragma unroll
        for (int i = 0; i < 7; ++i) {
            const int rid = (tid + 512 * i) >> 3;
            const bool isq = rid < 256;
            const int pos = isq ? q0 + (rid >> 2) : q0 - 128 + (rid - 256);
            const bf16_t* src = Z + (size_t)(b * 8192 + (pos >= 0 ? pos : 0)) * ZS + (isq ? C_AQ + (kvh * 4 + (rid & 3)) * 64 : C_AK + kvh * 64) + sub * 8;
            raw[i] = *(const u32x4*)src;
        }
#pragma unroll
        for (int i = 0; i < 7; ++i) {
            const int rid = (tid + 512 * i) >> 3;
            const bool isq = rid < 256;
            const int j = rid - 256;
            const int pos = isq ? q0 + (rid >> 2) : q0 - 128 + j;
            bf16_t* dst = (isq ? sQ + ((rid & 3) * 64 + (rid >> 2)) * 72 : sK + j * 72) + sub * 8;
            const u32x4 w = raw[i];
            float x[8] = {lo16(w.x), hi16(w.x), lo16(w.y), hi16(w.y), lo16(w.z), hi16(w.z), lo16(w.w), hi16(w.w)};
            float ss = 0.f;
#pragma unroll
            for (int e = 0; e < 8; ++e) ss += x[e] * x[e];
            ss += dpp_mov<0xB1>(ss); ss += dpp_mov<0x4E>(ss); ss += dpp_mov<0x141>(ss);
            const float rstd = rsqrtf(ss * (1.0f / 64.f) + EPSF);
            const float* gn = (isq ? p.q_norm_g : p.k_norm_g) + l * 64 + sub * 8;
            const f32x4 g0 = *(const f32x4*)gn, g1 = *(const f32x4*)(gn + 4);
#pragma unroll
            for (int e = 0; e < 8; ++e) x[e] = x[e] * rstd * (e < 4 ? g0[e] : g1[e - 4]);
            const float* rp = ROPE + (size_t)(pos >= 0 ? pos : 0) * 16;
#pragma unroll
            for (int e = 0; e < 8; ++e) {
                const float other = dpp_mov<0xB1>(x[e]);
                if (sub < 2) {
                    const float cs = rp[2 * e], sn = rp[2 * e + 1];
                    x[e] = sub == 0 ? x[e] * cs - other * sn : x[e] * cs + other * sn;
                }
            }
            u32x4 o;
            o.x = cvt_pk_bf16(x[0], x[1]); o.y = cvt_pk_bf16(x[2], x[3]); o.z = cvt_pk_bf16(x[4], x[5]); o.w = cvt_pk_bf16(x[6], x[7]);
            if (pos < 0) o = (u32x4){0u, 0u, 0u, 0u};
            *(u32x4*)dst = o;
            if (!isq && last && j >= 64) {
                float* op = p.out + O_PWK + ((size_t)((l * 2 + b) * 128 + (j - 64)) * 2 + kvh) * 64 + sub * 8;
                *(f32x4*)op = (f32x4){x[0], x[1], x[2], x[3]}; *(f32x4*)(op + 4) = (f32x4){x[4], x[5], x[6], x[7]};
            }
        }
    }
    for (int q = tid; q < 192 * 8; q += 512) {
        const int j = q >> 3, d0 = (q & 7) * 8, pos = q0 - 128 + j;
        u32x4 w = {0u, 0u, 0u, 0u};
        if (pos >= 0) w = *(const u32x4*)(Z + (size_t)(b * 8192 + pos) * ZS + C_AV + kvh * 64 + d0);
        const int pj = (j & ~31) + perm_pos(j & 31);
        bf16_t* d = sVt + d0 * 200 + pj;
        d[0] = (bf16_t)(w.x & 0xffff); d[200] = (bf16_t)(w.x >> 16); d[400] = (bf16_t)(w.y & 0xffff); d[600] = (bf16_t)(w.y >> 16);
        d[800] = (bf16_t)(w.z & 0xffff); d[1000] = (bf16_t)(w.z >> 16); d[1200] = (bf16_t)(w.w & 0xffff); d[1400] = (bf16_t)(w.w >> 16);
        if (last && j >= 64) {
            float* o = p.out + O_PWV + ((size_t)((l * 2 + b) * 128 + (j - 64)) * 2 + kvh) * 64 + d0;
            f32x4 a = {lo16(w.x), hi16(w.x), lo16(w.y), hi16(w.y)}, c = {lo16(w.z), hi16(w.z), lo16(w.w), hi16(w.w)};
            *(f32x4*)o = a; *(f32x4*)(o + 4) = c;
        }
    }
    __syncthreads();
    {
        const int hh = wid >> 1, t0 = (wid & 1) * 32, fr = lane & 15, fq = lane >> 4;
        bf16x8 qf[2][2];
#pragma unroll
        for (int qt = 0; qt < 2; ++qt)
#pragma unroll
            for (int ks = 0; ks < 2; ++ks) qf[qt][ks] = *(const bf16x8*)(sQ + (hh * 64 + t0 + 16 * qt + fr) * 72 + ks * 32 + fq * 8);
        u32x2 agv[2][4];
#pragma unroll
        for (int qt = 0; qt < 2; ++qt)
#pragma unroll
            for (int dt = 0; dt < 4; ++dt)
                agv[qt][dt] = *(const u32x2*)(Z + (size_t)(b * 8192 + q0 + t0 + 16 * qt + fr) * ZS + C_AG + (kvh * 4 + hh) * 64 + 16 * dt + 4 * fq);
        f32x4 s[10][2];
#pragma unroll
        for (int kt = 0; kt < 10; ++kt) {
            bf16x8 kf[2];
#pragma unroll
            for (int ks = 0; ks < 2; ++ks) kf[ks] = *(const bf16x8*)(sK + (t0 + 16 * kt + fr) * 72 + ks * 32 + fq * 8);
#pragma unroll
            for (int qt = 0; qt < 2; ++qt) {
                f32x4 a = {0.f, 0.f, 0.f, 0.f};
                a = __builtin_amdgcn_mfma_f32_16x16x32_bf16(kf[0], qf[qt][0], a, 0, 0, 0);
                a = __builtin_amdgcn_mfma_f32_16x16x32_bf16(kf[1], qf[qt][1], a, 0, 0, 0);
                s[kt][qt] = a;
            }
        }
        const float sink = p.sinks[l * 8 + kvh * 4 + hh];
        float inv[2];
#pragma unroll
        for (int qt = 0; qt < 2; ++qt) {
            const int t = t0 + 16 * qt + fr;
            float m = sink;
#pragma unroll
            for (int kt = 0; kt < 10; ++kt)
#pragma unroll
                for (int e = 0; e < 4; ++e) {
                    const int j = t0 + 16 * kt + 4 * fq + e;
                    const bool valid = (j >= t + 1) && (j <= t + 128) && (q0 - 128 + j >= 0);
                    const float v = valid ? s[kt][qt][e] * 0.125f : -INFINITY;
                    s[kt][qt][e] = v; m = fmaxf(m, v);
                }
            m = fmaxf(m, __shfl_xor(m, 16)); m = fmaxf(m, __shfl_xor(m, 32));
            float sum = 0.f;
#pragma unroll
            for (int kt = 0; kt < 10; ++kt)
#pragma unroll
                for (int e = 0; e < 4; ++e) { const float pv = __expf(s[kt][qt][e] - m); s[kt][qt][e] = pv; sum += pv; }
            sum += __shfl_xor(sum, 16); sum += __shfl_xor(sum, 32);
            inv[qt] = 1.0f / (sum + __expf(sink - m));
        }
        f32x4 o[4][2];
#pragma unroll
        for (int dt = 0; dt < 4; ++dt)
#pragma unroll
            for (int qt = 0; qt < 2; ++qt) o[dt][qt] = (f32x4){0.f, 0.f, 0.f, 0.f};
#pragma unroll
        for (int sp = 0; sp < 5; ++sp) {
            bf16x8 pf[2];
#pragma unroll
            for (int qt = 0; qt < 2; ++qt) {
                u32x4 w; w.x = cvt_pk_bf16(s[2 * sp][qt][0], s[2 * sp][qt][1]); w.y = cvt_pk_bf16(s[2 * sp][qt][2], s[2 * sp][qt][3]);
                w.z = cvt_pk_bf16(s[2 * sp + 1][qt][0], s[2 * sp + 1][qt][1]); w.w = cvt_pk_bf16(s[2 * sp + 1][qt][2], s[2 * sp + 1][qt][3]);
                pf[qt] = __builtin_bit_cast(bf16x8, w);
            }
#pragma unroll
            for (int dt = 0; dt < 4; ++dt) {
                const bf16x8 vf = *(const bf16x8*)(sVt + (16 * dt + fr) * 200 + t0 + 32 * sp + fq * 8);
#pragma unroll
                for (int qt = 0; qt < 2; ++qt) o[dt][qt] = __builtin_amdgcn_mfma_f32_16x16x32_bf16(vf, pf[qt], o[dt][qt], 0, 0, 0);
            }
        }
#pragma unroll
        for (int qt = 0; qt < 2; ++qt) {
            const size_t row = (size_t)(b * 8192 + q0 + t0 + 16 * qt + fr);
#pragma unroll
            for (int dt = 0; dt < 4; ++dt) {
                const int colx = (kvh * 4 + hh) * 64 + 16 * dt + 4 * fq;
                const u32x2 ag = agv[qt][dt];
                const f32x4 ov = o[dt][qt] * inv[qt];
                u32x2 w; w.x = cvt_pk_bf16(ov[0] * siluf(lo16(ag.x)), ov[1] * siluf(hi16(ag.x))); w.y = cvt_pk_bf16(ov[2] * siluf(lo16(ag.y)), ov[3] * siluf(hi16(ag.y)));
                *(u32x2*)((bf16_t*)(p.ws + W_MIX) + row * DM + colx) = w;
            }
        }
    }
    __syncthreads();
}

constexpr int NSPLIT = 4, SCAN_BLOCKS = 8 * NSPLIT;
constexpr int SL_W = 0, SL_QG = 64 * 272, SL_KD = SL_QG + 64 * 272, SL_AQK = SL_KD + 128 * 144, SL_BUF = SL_AQK + 64 * 144, SL_SS = 2 * SL_BUF, SL_TILE = SL_SS + 2 * 64 * 2 * 4,
              SL_TPITCH = 80, SL_END = SL_TILE + 2 * 64 * SL_TPITCH;
static_assert(SL_END <= LDS_USER, "scan LDS");
DI bf16x8 pack_b(const f32x4& a, const f32x4& b) {
    u32x4 w; w.x = cvt_pk_bf16(a[0], a[1]); w.y = cvt_pk_bf16(a[2], a[3]); w.z = cvt_pk_bf16(b[0], b[1]); w.w = cvt_pk_bf16(b[2], b[3]);
    return __builtin_bit_cast(bf16x8, w);
}
#define MFMA16(a, b, c) __builtin_amdgcn_mfma_f32_16x16x32_bf16((a), (b), (c), 0, 0, 0)
#define SFENCE() asm volatile("" ::: "memory")
DI void scan_chain(const Params& p, int l, int sb, const int n0, const int n1, unsigned char* smem, const int tid) {
    const int wid = tid >> 6, lane = tid & 63, fr = lane & 15, fq = lane >> 4;
    const int bh = sb & 7, cg = sb >> 3, b = bh >> 2, h = bh & 3;
    float* sSS = (float*)(smem + SL_SS);
    const int item0 = (b * 128) * 4 + h;
    if (wid >= 4) {
        const int lt = tid - 256;
        const unsigned char* gW = p.ws + W_PW; const unsigned char* gQ = p.ws + W_PQG; const unsigned char* gK = p.ws + W_PKD; const unsigned char* gA = p.ws + W_PAQK;
        const int r16 = lt >> 4, c16 = lt & 15, r8 = lt >> 3, c8 = lt & 7;
        const int dW = SL_W + r16 * 272 + c16 * 16, dQ = SL_QG + r16 * 272 + c16 * 16, dK = SL_KD + r8 * 144 + c8 * 16, dA = SL_AQK + r8 * 144 + c8 * 16;
        u32x4 st[14];
#define SCAN_LOAD(it_) do { const size_t i16 = (size_t)(it_) * 16384, i8 = (size_t)(it_) * 8192; \
            _Pragma("unroll") for (int i = 0; i < 4; ++i) { st[i] = *(const u32x4*)(gW + i16 + i * 4096 + lt * 16); st[4 + i] = *(const u32x4*)(gQ + i16 + i * 4096 + lt * 16); \
                st[8 + i] = *(const u32x4*)(gK + i16 + i * 4096 + lt * 16); } \
            st[12] = *(const u32x4*)(gA + i8 + lt * 16); st[13] = *(const u32x4*)(gA + i8 + 4096 + lt * 16); } while (0)
#define SCAN_STORE(bufp) do { unsigned char* bb_ = (bufp); \
            _Pragma("unroll") for (int i = 0; i < 4; ++i) { *(u32x4*)(bb_ + dW + i * 16 * 272) = st[i]; *(u32x4*)(bb_ + dQ + i * 16 * 272) = st[4 + i]; *(u32x4*)(bb_ + dK + i * 32 * 144) = st[8 + i]; } \
            *(u32x4*)(bb_ + dA) = st[12]; *(u32x4*)(bb_ + dA + 32 * 144) = st[13]; } while (0)
        SCAN_LOAD(item0 + 4 * n0);
        SCAN_STORE(smem);
        SCAN_LOAD(item0 + 4 * (n0 + 1));
        __syncthreads();
#pragma unroll 1
        for (int n = n0; n < n1; ++n) {
            if (n + 1 < n1) SCAN_STORE(smem + ((n + 1) & 1) * SL_BUF);
            SFENCE();
            if (n + 2 < n1) SCAN_LOAD(item0 + 4 * (n + 2));
            __syncthreads();
        }
#undef SCAN_LOAD
#undef SCAN_STORE
    } else if (wid >= 2) {
        const int ct = tid - 128;
        bf16_t* MIX = (bf16_t*)(p.ws + W_MIX);
        float* PSS = (float*)(p.ws + W_PSS);
        __syncthreads();
#pragma unroll 1
        for (int n = n0; n < n1; ++n) {
            __syncthreads();
            unsigned char* mixb = (unsigned char*)MIX + (size_t)(b * 8192 + n * 64) * (DM * 2);
            const float* ssw = sSS + (n & 1) * 128;
            const unsigned char* tile = smem + SL_TILE + (n & 1) * (64 * SL_TPITCH);
#pragma unroll
            for (int i = 0; i < 2; ++i) {
                const int q = ct + 128 * i, r = q >> 2, ch = q & 3;
                const u32x4 w = *(const u32x4*)(tile + r * SL_TPITCH + ch * 16);
                *(u32x4*)(mixb + (size_t)r * (DM * 2) + (512 + h * 128 + cg * 32 + ch * 8) * 2) = w;
                if (ch == 0) PSS[(size_t)(b * 8192 + n * 64 + r) * 16 + h * 4 + cg] = ssw[r * 2] + ssw[r * 2 + 1];
            }
        }
    } else {
        const int c0 = cg * 32 + wid * 16;
        const float* gU = (const float*)(p.ws + W_PU); const float* gGL = (const float*)(p.ws + W_PGL);
        const bf16_t* gG = (const bf16_t*)(p.ws + W_PG);
        float* Ssave = (float*)(p.ws + W_SST) + (size_t)bh * 16384;
        f32x4 S[8];
#pragma unroll
        for (int t = 0; t < 8; ++t)
#pragma unroll
            for (int e = 0; e < 4; ++e) S[t][e] = n0 ? Ssave[(size_t)(16 * t + 4 * fq + e) * 128 + c0 + fr] : 0.f;
        f32x4 un[4]; u32x4 dgn[2]; float gln = gGL[item0 + 4 * n0];
        const int lofs = ((c0 >> 4) * 64 + lane) * 16;
        {
            const f32x4* up = (const f32x4*)(gU + (size_t)(item0 + 4 * n0) * 8192 + lofs);
#pragma unroll
            for (int t = 0; t < 4; ++t) un[t] = up[t];
            const u32x4* gp = (const u32x4*)(gG + (size_t)(item0 + 4 * n0) * 8192 + lofs);
            dgn[0] = gp[0]; dgn[1] = gp[1];
        }
        __syncthreads();
        f32x4 vn[4]; u32x4 dgc[2]; float gl = gln;
#pragma unroll
        for (int t = 0; t < 4; ++t) vn[t] = un[t];
        dgc[0] = dgn[0]; dgc[1] = dgn[1];
        const int offW = fr * 272 + fq * 16, offA = fr * 144 + fq * 16;
#pragma unroll 1
        for (int n = n0; n < n1; ++n) {
            const int item = item0 + 4 * n;
            const unsigned char* buf = smem + (n & 1) * SL_BUF;
            float* ssw = sSS + (n & 1) * 128;
            unsigned char* tile = smem + SL_TILE + (n & 1) * (64 * SL_TPITCH);
            SFENCE();
            if (n + 1 < n1) {
                const f32x4* up = (const f32x4*)(gU + (size_t)(item + 4) * 8192 + lofs);
#pragma unroll
                for (int t = 0; t < 4; ++t) un[t] = up[t];
                const u32x4* gp = (const u32x4*)(gG + (size_t)(item + 4) * 8192 + lofs);
                dgn[0] = gp[0]; dgn[1] = gp[1];
                gln = gGL[item + 4];
            }
            SFENCE();
            bf16x8 Sb[4];
#pragma unroll
            for (int s = 0; s < 4; ++s) Sb[s] = pack_b(S[2 * s], S[2 * s + 1]);
            f32x4 o[4];
#pragma unroll
            for (int t = 0; t < 4; ++t) o[t] = (f32x4){0.f, 0.f, 0.f, 0.f};
            bf16x8 fa[8], fb[8];
#define LDWQ(dst, t_) _Pragma("unroll") for (int s = 0; s < 4; ++s) { dst[2 * s] = *(const bf16x8*)(buf + SL_W + (16 * (t_)) * 272 + offW + s * 64); dst[2 * s + 1] = *(const bf16x8*)(buf + SL_QG + (16 * (t_)) * 272 + offW + s * 64); }
#define MMWQ(src, t_) _Pragma("unroll") for (int s = 0; s < 4; ++s) { vn[t_] = MFMA16(src[2 * s], Sb[s], vn[t_]); o[t_] = MFMA16(src[2 * s + 1], Sb[s], o[t_]); }
#define LDAQ(dst) _Pragma("unroll") for (int t = 0; t < 4; ++t) _Pragma("unroll") for (int s = 0; s < 2; ++s) dst[2 * t + s] = *(const bf16x8*)(buf + SL_AQK + (16 * t) * 144 + offA + s * 64);
#define MMAQ(src) _Pragma("unroll") for (int t = 0; t < 4; ++t) _Pragma("unroll") for (int s = 0; s < 2; ++s) o[t] = MFMA16(src[2 * t + s], vb[s], o[t]);
#define LDKD(dst, tp) _Pragma("unroll") for (int t = 0; t < 4; ++t) _Pragma("unroll") for (int s = 0; s < 2; ++s) dst[2 * t + s] = *(const bf16x8*)(buf + SL_KD + (16 * (4 * (tp) + t)) * 144 + offA + s * 64);
#define MMKD(src, tp) _Pragma("unroll") for (int t = 0; t < 4; ++t) { S[4 * (tp) + t] = S[4 * (tp) + t] * gl; _Pragma("unroll") for (int s = 0; s < 2; ++s) S[4 * (tp) + t] = MFMA16(src[2 * t + s], vb[s], S[4 * (tp) + t]); }
#define SCHED() __builtin_amdgcn_sched_barrier(0)
            LDWQ(fa, 0); SFENCE(); SCHED();
            LDWQ(fb, 1); SCHED(); MMWQ(fa, 0); SFENCE(); SCHED();
            LDWQ(fa, 2); SCHED(); MMWQ(fb, 1); SFENCE(); SCHED();
            LDWQ(fb, 3); SCHED(); MMWQ(fa, 2); SFENCE(); SCHED();
            LDAQ(fa); SCHED(); MMWQ(fb, 3); SFENCE(); SCHED();
            bf16x8 vb[2];
            LDKD(fb, 0); SCHED();
            vb[0] = pack_b(vn[0], vn[1]); vb[1] = pack_b(vn[2], vn[3]);
            MMAQ(fa); SFENCE(); SCHED();
            LDKD(fa, 1); SCHED(); MMKD(fb, 0); SFENCE(); SCHED();
            MMKD(fa, 1); SFENCE(); SCHED();
#undef SCHED
#undef LDWQ
#undef MMWQ
#undef LDAQ
#undef MMAQ
#undef LDKD
#undef MMKD
            {
                float x[16];
#pragma unroll
                for (int t = 0; t < 4; ++t)
#pragma unroll
                    for (int e = 0; e < 4; ++e) x[t * 4 + e] = o[t][e] * o[t][e];
                const float tot = row16_transpose_reduce(x, fr);
                ssw[(16 * (fr >> 2) + 4 * fq + (fr & 3)) * 2 + wid] = tot;
            }
            {
                unsigned char* tp = tile + (4 * fq) * SL_TPITCH + (wid * 16 + fr) * 2;
#pragma unroll
                for (int t = 0; t < 4; ++t)
#pragma unroll
                    for (int e = 0; e < 4; ++e) {
                        const unsigned gw = dgc[t >> 1][(t & 1) * 2 + (e >> 1)];
                        const float gate = (e & 1) ? hi16(gw) : lo16(gw);
                        const float v = o[t][e] * gate;
                        *(bf16_t*)(tp + (16 * t + e) * SL_TPITCH) = (bf16_t)cvt_pk_bf16(v, v);
                    }
            }
            __syncthreads();
#pragma unroll
            for (int t = 0; t < 4; ++t) vn[t] = un[t];
            dgc[0] = dgn[0]; dgc[1] = dgn[1]; gl = gln;
        }
        float* Sout = n1 == 128 ? p.out + O_PDELTA + ((size_t)(l * 2 + b) * 4 + h) * 16384 : Ssave;
#pragma unroll
        for (int t = 0; t < 8; ++t)
#pragma unroll
            for (int e = 0; e < 4; ++e) Sout[(size_t)(16 * t + 4 * fq + e) * 128 + c0 + fr] = S[t][e];
    }
    __syncthreads();
}

DI void post_phase(const Params& p, const int tid) {
    bf16_t* MIX = (bf16_t*)(p.ws + W_MIX);
    const float* PSS = (const float*)(p.ws + W_PSS);
    for (int task = (blockIdx.x - 32) * 512 + tid; task < MP * 64; task += (gridDim.x - 32) * 512) {
        const int row = task >> 6, hc = task & 63, hh = hc >> 4, ch = hc & 15;
        const f32x4 ps = *(const f32x4*)(PSS + (size_t)row * 16 + hh * 4);
        const float rstd = rsqrtf(((ps[0] + ps[1]) + (ps[2] + ps[3])) * (1.0f / 128.f) + EPSF);
        u32x4* ptr = (u32x4*)(MIX + (size_t)row * DM + 512 + hh * 128 + ch * 8);
        const u32x4 w = *ptr;
        u32x4 ov;
        ov.x = cvt_pk_bf16(lo16(w.x) * rstd, hi16(w.x) * rstd); ov.y = cvt_pk_bf16(lo16(w.y) * rstd, hi16(w.y) * rstd);
        ov.z = cvt_pk_bf16(lo16(w.z) * rstd, hi16(w.z) * rstd); ov.w = cvt_pk_bf16(lo16(w.w) * rstd, hi16(w.w) * rstd);
        *ptr = ov;
    }
}

#ifndef REP0
#define REP0 1
#endif
#ifndef REP1
#define REP1 1
#endif
#ifndef REP2
#define REP2 1
#endif
#ifndef REP2A
#define REP2A 1
#endif
#ifndef REPP
#define REPP 1
#endif
#ifndef REPO
#define REPO 1
#endif
#ifndef REP1LIM
#define REP1LIM 1792
#endif
#ifndef PROBE_K
#define PROBE_K (-1)
#endif
#ifndef ITEM_PROBE
#define ITEM_PROBE (-1)
#endif
#ifndef A_EXTRA
#define A_EXTRA 0
#endif
#ifndef ITEM_GAP
#define ITEM_GAP 0
#endif
#ifndef PH_EN
#define PH_EN 1023
#endif
__global__ void __launch_bounds__(512, 2) hybrid_fwd(Params p) {
    extern __shared__ __attribute__((aligned(16))) unsigned char smem[];
    XcdBarrier xb;
    if (p.coop) {
        volatile XB_LAS unsigned* st = (volatile XB_LAS unsigned*)(XB_LAS unsigned char*)(smem + LDS_USER);
        if (threadIdx.x == 0) { st[0] = 0u; st[1] = 0u; }
        __syncthreads();
        xb = xcd_barrier_post((unsigned*)(p.ws + W_BAR), st);
    }
    for (int ph = p.phase_lo; ph < p.phase_hi; ++ph) {
        const bool probe_hit = (PROBE_K == 6) ? (ph == 0) : (PROBE_K >= 0 && ph > 0 && (ph - 1) % 6 == PROBE_K);
        unsigned long long probe_t0 = 0; if (probe_hit) probe_t0 = __builtin_amdgcn_s_memrealtime();
        int tid = threadIdx.x; asm volatile("" : "+v"(tid));
        if (ph == 0) {
            for (int rep = 0; rep < REPP; ++rep) { if (PH_EN & 1) phase0(p, smem, tid); }
        } else {
            const int l = (ph - 1) / 6, k6 = (ph - 1) % 6, k = k6 >= 4 ? k6 - 1 : k6;
            if (k6 == 0) {
                pg8::Gemm g; g.A = (const bf16_t*)(p.ws + W_XB); g.Bt = (const bf16_t*)(p.ws + W_WINT) + (size_t)l * NPAD * DM; g.M = MT; g.N = NPAD; g.K = DM; g.KL = DM;
                pg8::StaticOrder so; so.init(MT, NPAD, gridDim.x, blockIdx.x);
                EpiIn e; e.Z = (bf16_t*)(p.ws + W_Z); e.z8 = (float*)(p.ws + W_Z8); e.ss = (const float*)(p.ws + W_SS) + (size_t)l * MT * 16;
                if (PH_EN & 2) pg8::gemm_phase<EpiIn, pg8::StaticOrder, false>((PG8_LAS unsigned char*)smem, g, so, e, nullptr, tid);
                {
                    const int nunits = (MT / 256) * (NPAD / 256), full = nunits / (int)gridDim.x, rem = nunits - full * (int)gridDim.x;
                    if (l < 3 && rem > 0 && (int)blockIdx.x >= rem) { __syncthreads(); weights_layer(p, l + 1, (int)blockIdx.x - rem, (int)gridDim.x - rem, smem, tid); }
                }
            } else if (k6 <= 3) {
                const bool scanner = (k6 >= 2) && (blockIdx.x < SCAN_BLOCKS);
                if (scanner) { if (PH_EN & 32) scan_chain(p, l, blockIdx.x, k6 == 2 ? 0 : 64, k6 == 2 ? 64 : 128, smem, tid); }
                else {
                    const int wk = k6 == 1 ? (int)blockIdx.x : (int)blockIdx.x - SCAN_BLOCKS, nwk = k6 == 1 ? (int)gridDim.x : (int)gridDim.x - SCAN_BLOCKS;
                    if (k6 <= 2 && wk < 512) {
                        const int hf = k6 - 1;
                        PrepPre pre; float cw0[3][4], cw1[3][4];
                        {
                            const int c = 2 * (tid & 63), h = wk & 3;
#pragma unroll
                            for (int part = 0; part < 3; ++part)
#pragma unroll
                                for (int j = 0; j < 4; ++j) { const float* cp = p.conv_w + (size_t)(l * 4 + j) * 1536 + part * 512 + h * 128 + c; cw0[part][j] = cp[0]; cw1[part][j] = cp[1]; }
                        }
#define PREP_ITEM_OF(j_) ((((j_) >> 8) * 128 + 64 * hf + (((j_) >> 2) & 63)) * 4 + ((j_) & 3))
                        prep_preload(p, PREP_ITEM_OF(wk), tid, pre);
                        for (int j = wk; j < 512; j += nwk) {
                            asm volatile("" : "+v"(tid));
                            const int nj = j + nwk;
                            if (PH_EN & 4) prep_item(p, l, PREP_ITEM_OF(j), nj < 512 ? PREP_ITEM_OF(nj) : -1, pre, cw0, cw1, smem, tid);
                        }
#undef PREP_ITEM_OF
                    }
                    if (k6 == 3) {
                        unsigned* ctr = (unsigned*)(p.ws + W_CTR) + l;
                        volatile unsigned* qw = (volatile unsigned*)(smem + LDS_USER + 8);
                        for (;;) {
                            asm volatile("" : "+v"(tid));
                            if (tid == 0) *qw = atomicAdd(ctr, 1u);
                            __syncthreads();
                            const int it = __builtin_amdgcn_readfirstlane((int)*qw);
                            __syncthreads();
                            if (it >= 1280) break;
                            if (it < 256) { if (PH_EN & 16) sattn_item(p, l, it, smem, tid); }
                            else if (it < 768) { if (PH_EN & 64) pattn_item(p, l, it - 256, smem, tid); }
                            else { if (PH_EN & 8) sdelta_item(p, l, it - 768, smem, tid); }
                        }
                    }
                }
            } else {
                if (k == 3 && blockIdx.x >= 32) { if (PH_EN & 256) post_phase(p, tid); }
                else {
                    const int ks = blockIdx.x >> 3, j = blockIdx.x & 7;
                    pg8::Gemm g; g.A = (const bf16_t*)(p.ws + W_MIX); g.Bt = (const bf16_t*)(p.ws + W_WOUTT) + (size_t)l * DM * DM; g.M = MT; g.N = DM; g.K = DM; g.KL = DM;
                    OutOrder so; so.so.init(MP, DM, gridDim.x, blockIdx.x); so.fixed = (k == 3); so.fu.pm = 64 + (j >> 2); so.fu.pn = j & 3;
                    EpiOut e; e.xin_p = l == 0 ? p.x_prompt : p.out + O_YP; e.xin_s = l == 0 ? p.x_sample : p.out + O_YS; e.xout = p.out;
                    e.xb = (bf16_t*)(p.ws + W_XB); e.ssn = l < 3 ? (float*)(p.ws + W_SS) + (size_t)(l + 1) * MT * 16 : nullptr; e.part = nullptr;
                    if (k == 3) { g.A += ks * 256; g.Bt += ks * 256; g.KL = 256; e.part = (float*)(p.ws + W_PART) + (size_t)ks * MS * DM; }
                    else if ((tid >> 6) < 2) {
                        const int lane = tid & 63;
                        for (int srow = blockIdx.x * 2 + (tid >> 6); srow < MS; srow += gridDim.x * 2) {
                        const float* xs = e.xin_s + (size_t)srow * DM; const float* pp = (const float*)(p.ws + W_PART) + (size_t)srow * DM;
                        float* xo = p.out + O_YS + (size_t)srow * DM; bf16_t* xbo = e.xb + (size_t)(MP + srow) * DM;
                        float sq = 0.f;
#pragma unroll
                        for (int jj = 0; jj < 4; ++jj) {
                            const int cix = (lane + 64 * jj) * 4;
                            f32x4 v = *(const f32x4*)(xs + cix);
#pragma unroll
                            for (int q = 0; q < 4; ++q) v = v + *(const f32x4*)(pp + (size_t)q * MS * DM + cix);
                            *(f32x4*)(xo + cix) = v;
                            sq += v[0] * v[0] + v[1] * v[1] + v[2] * v[2] + v[3] * v[3];
                            if (e.ssn) { u32x2 o; o.x = cvt_pk_bf16(v[0], v[1]); o.y = cvt_pk_bf16(v[2], v[3]); *(u32x2*)(xbo + cix) = o; }
                        }
                        sq = wave_sum(sq);
                        if (e.ssn && lane < 16) e.ssn[(size_t)(MP + srow) * 16 + lane] = lane == 0 ? sq : 0.f;
                        }
                    }
                    if (PH_EN & 128) pg8::gemm_phase<EpiOut, OutOrder, false>((PG8_LAS unsigned char*)smem, g, so, e, nullptr, tid);
                }
            }
        }
        if (p.coop && ph + 1 < p.phase_hi) { if (p.coop == 2) cg::this_grid().sync(); else xcd_barrier(xb); }
        if (probe_hit) { const unsigned long long t1 = __builtin_amdgcn_s_memrealtime(); while (__builtin_amdgcn_s_memrealtime() - t1 < t1 - probe_t0) __builtin_amdgcn_s_sleep(8); }
    }
}

#ifndef N_LAUNCH_MODE
#define N_LAUNCH_MODE 1
#endif
extern "C" void kernel_launch(void* const* d_in, const int* in_sizes, int n_in, void* d_out, int out_size, void* d_ws, size_t ws_size, hipStream_t stream) {
    static int grid = 0;
    if (grid == 0) {
        if (n_in != 16 || ws_size < W_END) { fprintf(stderr, "kernel_launch: unexpected n_in %d or ws %zu (< %zu)\n", n_in, ws_size, (size_t)W_END); grid = -1; return; }
        int dev = 0, cus = 0;
        hipGetDevice(&dev); hipDeviceGetAttribute(&cus, hipDeviceAttributeMultiprocessorCount, dev);
        if (hipFuncSetAttribute((const void*)hybrid_fwd, hipFuncAttributeMaxDynamicSharedMemorySize, LDS_BYTES) != hipSuccess) { fprintf(stderr, "hipFuncSetAttribute failed\n"); grid = -1; return; }
        int per_cu = 0;
        if (hipOccupancyMaxActiveBlocksPerMultiprocessor(&per_cu, (const void*)hybrid_fwd, 512, LDS_BYTES) != hipSuccess || per_cu < 1) fprintf(stderr, "occupancy query says %d\n", per_cu);
        (void)hipGetLastError();
        grid = cus > 0 ? cus : 256;
    }
    if (grid < 0) return;
    Params p{};
    p.x_prompt = (const float*)d_in[0]; p.x_sample = (const float*)d_in[1]; p.cache_k = (const float*)d_in[2]; p.cache_v = (const float*)d_in[3];
    p.state_conv = (const float*)d_in[4]; p.state_delta = (const float*)d_in[5]; p.norm_g = (const float*)d_in[6]; p.w_in = (const float*)d_in[7];
    p.q_norm_g = (const float*)d_in[8]; p.k_norm_g = (const float*)d_in[9]; p.sinks = (const float*)d_in[10]; p.conv_w = (const float*)d_in[11];
    p.a_log = (const float*)d_in[12]; p.dt_bias = (const float*)d_in[13]; p.dn_norm_g = (const float*)d_in[14]; p.w_out = (const float*)d_in[15];
    p.out = (float*)d_out; p.ws = (unsigned char*)d_ws;
#if N_LAUNCH_MODE == 1
    hipMemsetAsync((unsigned char*)d_ws + W_BAR, 0, (size_t)XCD_BAR_WORDS * 4 + 64, stream);
    p.phase_lo = 0; p.phase_hi = 25; p.coop = 1;
    void* args[] = {&p};
    hipError_t e = hipLaunchCooperativeKernel((const void*)hybrid_fwd, dim3(grid), dim3(512), args, LDS_BYTES, stream);
    if (e != hipSuccess) fprintf(stderr, "cooperative launch failed: %s (grid %d)\n", hipGetErrorString(e), grid);
#else
    for (int ph = 0; ph < 25; ++ph) {
        p.phase_lo = ph; p.phase_hi = ph + 1; p.coop = 0;
        hipLaunchKernelGGL(hybrid_fwd, dim3(grid), dim3(512), LDS_BYTES, stream, p);
    }
#endif
}
```
